# Optimizing an MI355X kernel written in HIP

```python
import math
import jax, jax.numpy as jnp
from jax import lax
import numpy as np

D_MODEL = 2048
BATCH = 1
SEQ = 16384
DEPTH = 1

MIX_WIDTH = D_MODEL
A_HEAD_DIM = 128
A_WIDTH = MIX_WIDTH // 2
A_HEADS = A_WIDTH // A_HEAD_DIM
A_PATTERNS = ((128, 1), (512, 4), (2048, 16))
B_HEAD_DIM = 64
B_WIDTH = MIX_WIDTH - A_WIDTH
B_HEADS = B_WIDTH // B_HEAD_DIM
B_KV_HEADS = 2
B_GROUP = B_HEADS // B_KV_HEADS
B_KV_WIDTH = B_KV_HEADS * B_HEAD_DIM
B_WINDOW = 128
IN_WIDTH = 3 * A_WIDTH + B_WIDTH + 2 * B_KV_WIDTH
FF_MULTIPLE = 256
D_FF = ((8 * D_MODEL + 3 * FF_MULTIPLE - 1) // (3 * FF_MULTIPLE)) * FF_MULTIPLE
BLOCK = 128
ROPE_THETA = 10000.0
ALPHA = (2 * DEPTH) ** 0.25
BETA = (8 * DEPTH) ** -0.25
LN_EPS = 1e-5
RMS_EPS = 1e-6

kernel_name = "hymba_dilated_sinkswa_deepnorm_swiglu"


def layer_norm(x, g, b):
    xf = x.astype(jnp.float32)
    mu = xf.mean(-1, keepdims=True)
    var = jnp.square(xf - mu).mean(-1, keepdims=True)
    return ((xf - mu) * lax.rsqrt(var + LN_EPS) * g + b).astype(x.dtype)


def rms_norm(x, g):
    xf = x.astype(jnp.float32)
    return xf * lax.rsqrt(jnp.square(xf).mean(-1, keepdims=True) + RMS_EPS) * g


def rope(x, pos):
    half = x.shape[-1] // 2
    inv_freq = ROPE_THETA ** (-jnp.arange(half, dtype=jnp.float32) / half)
    ang = pos.astype(jnp.float32)[:, None] * inv_freq[None, :]
    cos = jnp.cos(ang)[None, :, None, :]
    sin = jnp.sin(ang)[None, :, None, :]
    x1 = x[..., :half].astype(jnp.float32)
    x2 = x[..., half:].astype(jnp.float32)
    return jnp.concatenate([x1 * cos - x2 * sin, x2 * cos + x1 * sin], axis=-1).astype(x.dtype)


def banded_attention(q, k, v, max_dist):
    N, L, KV, G, D = q.shape
    nb = L // BLOCK
    qb = (q * (1.0 / math.sqrt(D))).reshape(N, nb, BLOCK, KV, G, D)

    def with_prev(t):
        t = t.reshape(N, nb, BLOCK, KV, D)
        prev = jnp.pad(t, ((0, 0), (1, 0), (0, 0), (0, 0), (0, 0)))[:, :-1]
        return jnp.concatenate([prev, t], axis=2)

    kk = with_prev(k)
    vv = with_prev(v)
    s = jnp.einsum('nbqkgd,nbskd->nbkgqs', qb, kk, preferred_element_type=jnp.float32)
    qi = jnp.arange(BLOCK)[:, None]
    kj = jnp.arange(2 * BLOCK)[None, :]
    dist = qi + BLOCK - kj
    band = (dist >= 0) & (dist <= max_dist)
    key_pos = jnp.arange(nb)[:, None] * BLOCK + jnp.arange(2 * BLOCK)[None, :] - BLOCK
    valid = band[None, :, :] & (key_pos >= 0)[:, None, :]
    s = jnp.where(valid[None, :, None, None], s, -jnp.inf)
    mx = s.max(-1)
    p = jnp.exp(s - mx[..., None])
    l = p.sum(-1)
    o = jnp.einsum('nbkgqs,nbskd->nbqkgd', p, vv.astype(jnp.float32))
    mx = jnp.moveaxis(mx, -1, 2)
    l = jnp.moveaxis(l, -1, 2)
    o = o / l[..., None]
    return (o.reshape(N, L, KV, G, D), mx.reshape(N, L, KV, G), l.reshape(N, L, KV, G))


def dilated_mixture_attention(q, k, v):
    B, S, H, D = q.shape
    outs, maxes, dens = [], [], []
    for window, dil in A_PATTERNS:
        L = S // dil
        Lp = -(-L // BLOCK) * BLOCK

        def stride_gather(t):
            t = jnp.swapaxes(t.reshape(B, L, dil, H, D), 1, 2).reshape(B * dil, L, H, D)
            return jnp.pad(t, ((0, 0), (0, Lp - L), (0, 0), (0, 0)))

        def unstride(t):
            t = t[:, :L, :, 0]
            t = t.reshape((B, dil, L) + t.shape[2:])
            return jnp.swapaxes(t, 1, 2).reshape((B, S) + t.shape[3:])

        o, mx, l = banded_attention(stride_gather(q)[:, :, :, None], stride_gather(k),
                                    stride_gather(v), window // dil)
        outs.append(unstride(o))
        maxes.append(unstride(mx))
        dens.append(unstride(l))
    o = jnp.stack(outs)
    mx = jnp.stack(maxes)
    l = jnp.stack(dens)
    w = l * jnp.exp(mx - mx.max(0))
    return (w[..., None] * o).sum(0) / w.sum(0)[..., None]


def sink_window_attention(q, k, v, sinks):
    o, mx, l = banded_attention(q, k, v, B_WINDOW - 1)
    sink = sinks.astype(jnp.float32).reshape(B_KV_HEADS, B_GROUP)
    m_all = jnp.maximum(mx, sink)
    num = l * jnp.exp(mx - m_all)
    return o * (num / (num + jnp.exp(sink - m_all)))[..., None]


def token_mixer(x, w_in, b_in, sinks, g_mix_a, g_mix_b, w_out):
    B, S, _ = x.shape
    pos = jnp.arange(S)
    proj = jnp.einsum('bsd,de->bse', x, w_in) + b_in
    cuts = [A_WIDTH, 2 * A_WIDTH, 3 * A_WIDTH, 3 * A_WIDTH + B_WIDTH, 3 * A_WIDTH + B_WIDTH + B_KV_WIDTH]
    qa, ka, va, qb, kb, vb = jnp.split(proj, cuts, axis=-1)
    qa = rope(qa.reshape(B, S, A_HEADS, A_HEAD_DIM), pos)
    ka = rope(ka.reshape(B, S, A_HEADS, A_HEAD_DIM), pos)
    va = va.reshape(B, S, A_HEADS, A_HEAD_DIM)
    ya = dilated_mixture_attention(qa, ka, va).reshape(B, S, A_WIDTH)
    qb = rope(qb.reshape(B, S, B_HEADS, B_HEAD_DIM), pos).reshape(B, S, B_KV_HEADS, B_GROUP, B_HEAD_DIM)
    kb = rope(kb.reshape(B, S, B_KV_HEADS, B_HEAD_DIM), pos)
    vb = vb.reshape(B, S, B_KV_HEADS, B_HEAD_DIM)
    yb = sink_window_attention(qb, kb, vb, sinks).reshape(B, S, B_WIDTH)
    y = jnp.concatenate([rms_norm(ya, g_mix_a), rms_norm(yb, g_mix_b)], axis=-1).astype(x.dtype)
    return jnp.einsum('bse,ed->bsd', y, w_out)


def swiglu(x, w_up, w_down):
    gate, up = jnp.split(jnp.einsum('bsd,df->bsf', x, w_up), 2, axis=-1)
    return jnp.einsum('bsf,fd->bsd', jax.nn.silu(gate) * up, w_down)


def setup_inputs(seed: int = 0) -> dict:
    key = jax.random.key(seed)
    ks = jax.random.split(key, 14)
    f32 = jnp.float32
    x = jax.random.normal(ks[0], (BATCH, SEQ, D_MODEL), f32)
    col_scale = jnp.asarray(np.concatenate([
        np.ones(2 * A_WIDTH, np.float32), np.full(A_WIDTH, BETA, np.float32),
        np.ones(B_WIDTH + B_KV_WIDTH, np.float32), np.full(B_KV_WIDTH, BETA, np.float32)]))
    w_in = jax.random.normal(ks[1], (DEPTH, D_MODEL, IN_WIDTH), f32) * (D_MODEL ** -0.5) * col_scale
    b_in = 0.02 * jax.random.normal(ks[2], (DEPTH, IN_WIDTH), f32)
    sinks = 0.5 * jax.random.normal(ks[3], (DEPTH, B_HEADS), f32)
    g_mix_a = 1.0 + 0.02 * jax.random.normal(ks[4], (DEPTH, A_WIDTH), f32)
    g_mix_b = 1.0 + 0.02 * jax.random.normal(ks[5], (DEPTH, B_WIDTH), f32)
    w_out = jax.random.normal(ks[6], (DEPTH, MIX_WIDTH, D_MODEL), f32) * (MIX_WIDTH ** -0.5) * BETA
    ln1_g = 1.0 + 0.02 * jax.random.normal(ks[7], (DEPTH, D_MODEL), f32)
    ln1_b = 0.02 * jax.random.normal(ks[8], (DEPTH, D_MODEL), f32)
    w_up = jax.random.normal(ks[9], (DEPTH, D_MODEL, 2 * D_FF), f32) * (D_MODEL ** -0.5) * BETA
    w_down = jax.random.normal(ks[10], (DEPTH, D_FF, D_MODEL), f32) * (D_FF ** -0.5) * BETA
    ln2_g = 1.0 + 0.02 * jax.random.normal(ks[11], (DEPTH, D_MODEL), f32)
    ln2_b = 0.02 * jax.random.normal(ks[12], (DEPTH, D_MODEL), f32)
    return {"x": x, "w_in": w_in, "b_in": b_in, "sinks": sinks, "g_mix_a": g_mix_a,
            "g_mix_b": g_mix_b, "w_out": w_out, "ln1_g": ln1_g, "ln1_b": ln1_b,
            "w_up": w_up, "w_down": w_down, "ln2_g": ln2_g, "ln2_b": ln2_b}


def reference(x, w_in, b_in, sinks, g_mix_a, g_mix_b, w_out, ln1_g, ln1_b, w_up, w_down, ln2_g, ln2_b):
    for i in range(DEPTH):
        mix = token_mixer(x, w_in[i], b_in[i], sinks[i], g_mix_a[i], g_mix_b[i], w_out[i])
        x = layer_norm(ALPHA * x + mix, ln1_g[i], ln1_b[i])
        x = layer_norm(ALPHA * x + swiglu(x, w_up[i], w_down[i]), ln2_g[i], ln2_b[i])
    return x
```

```cpp
#include <hip/hip_runtime.h>
#include <hip/hip_cooperative_groups.h>
#include <cstdio>
#include <cstdint>
#include <cmath>
namespace pg8 {
#define PG8_LAS __attribute__((address_space(3)))
typedef unsigned short bf16_t;
typedef short bf16x8 __attribute__((ext_vector_type(8)));
typedef float f32x4 __attribute__((ext_vector_type(4)));
typedef unsigned u32x4 __attribute__((ext_vector_type(4)));
constexpr int BM = 256, BK = 64, HALF = 128, HTB = HALF * BK * 2  , STAGE_BYTES = 8 * HTB, NXCD = 8, WGM = 8;

__host__ __device__ __forceinline__ int lds_byte(int r, int c) { const int st = (r >> 4) * 2 + (c >> 5), rr = r & 15, cc = c & 31, ob = rr * 64 + cc * 2; return st * 1024 + (ob ^ (((ob >> 9) & 1) << 5)); }
__host__ __device__ __forceinline__ void stage_rc(int b, int& R, int& C) { const int st = b / 1024, sb = b % 1024, swz = sb ^ (((sb >> 9) & 1) << 5); R = (st >> 1) * 16 + swz / 64; C = (st & 1) * 32 + (swz % 64) / 2; }
__host__ __device__ __forceinline__ int perm32(int rho) { const int n = rho >> 4, i = rho & 15; return 8 * (i >> 2) + 4 * n + (i & 3); }

struct Unit { int pm, pn; };
struct Gemm { const bf16_t* A; const bf16_t* Bt; int M, N, K; };

struct StaticOrder {
    int nM, nN, nwg, G, c;
    __host__ __device__ void init(int M, int N, int G_, int c_) { nM = M / BM; nN = N / BM; nwg = nM * nN; G = G_; c = c_; }
    __host__ __device__ bool next(int i, Unit& u) const {
        const long L = (long)i * G + c; if (L >= nwg) return false;
        int wgid = (int)L; { const int q = nwg / NXCD, r = nwg % NXCD, xcd = wgid % NXCD, off = wgid / NXCD; wgid = (xcd < r ? xcd * (q + 1) : r * (q + 1) + (xcd - r) * q) + off; }
        const int nig = WGM * nN, gid = wgid / nig, fm = gid * WGM, gsz = (nM - fm) < WGM ? (nM - fm) : WGM;
        u.pm = fm + ((wgid % nig) % gsz); u.pn = (wgid % nig) / gsz; return true;
    }
    __device__ __forceinline__ void a_ready(const Unit&) const {}
    __device__ __forceinline__ void done(const Unit&) const {}
};

__device__ __forceinline__ unsigned cvt_pk_bf16(float lo, float hi) { unsigned r; asm volatile("v_cvt_pk_bf16_f32 %0, %1, %2" : "=v"(r) : "v"(lo), "v"(hi)); return r; }
struct EpiBf16 {
    static constexpr bool PERM = true, AFTER_DRAIN = false;
    bf16_t* O; int ldc; const float* bias;
    __device__ __forceinline__ void operator()(const f32x4 (&acc)[2][2][4][2], const Unit& u, int wr, int wc, int fr, int fq) const {
        const int row0 = u.pm * BM + wr * 64 + fr; const int col0 = u.pn * BM + wc * 32 + 8 * fq;
        f32x4 bv[2][2];
#pragma unroll
        for (int bj = 0; bj < 2; ++bj)
#pragma unroll
            for (int n = 0; n < 2; ++n) bv[bj][n] = *(const f32x4*)(bias + col0 + bj * HALF + 4 * n);
#pragma unroll
        for (int ai = 0; ai < 2; ++ai)
#pragma unroll
            for (int m = 0; m < 4; ++m) { bf16_t* rowp = O + (size_t)(row0 + ai * HALF + m * 16) * ldc + col0;
#pragma unroll
                for (int bj = 0; bj < 2; ++bj) { const f32x4 v0 = acc[ai][bj][m][0] + bv[bj][0], v1 = acc[ai][bj][m][1] + bv[bj][1];
                    u32x4 w; w.x = cvt_pk_bf16(v0[0], v0[1]); w.y = cvt_pk_bf16(v0[2], v0[3]); w.z = cvt_pk_bf16(v1[0], v1[1]); w.w = cvt_pk_bf16(v1[2], v1[3]);
                    *(u32x4*)(rowp + bj * HALF) = w; } }
    }
};
struct EpiRes {
    static constexpr bool PERM = false, AFTER_DRAIN = false;
    const float* base; float* out; int ldc; float alpha;
    __device__ __forceinline__ void operator()(const f32x4 (&acc)[2][2][4][2], const Unit& u, int wr, int wc, int fr, int fq) const {
        const int col0 = u.pn * BM + wc * 32 + 4 * fq;
#pragma unroll
        for (int ai = 0; ai < 2; ++ai)
#pragma unroll
            for (int m = 0; m < 4; ++m) { const size_t off = (size_t)(u.pm * BM + ai * HALF + wr * 64 + m * 16 + fr) * ldc + col0;
#pragma unroll
                for (int bj = 0; bj < 2; ++bj)
#pragma unroll
                    for (int n = 0; n < 2; ++n) { const f32x4 bs = *(const f32x4*)(base + off + bj * HALF + n * 16);
                        *(f32x4*)(out + off + bj * HALF + n * 16) = bs * alpha + acc[ai][bj][m][n]; } }
    }
};
struct EpiSwiglu {
    static constexpr bool PERM = true, AFTER_DRAIN = false;
    bf16_t* O; int ldc;
    __device__ __forceinline__ void operator()(const f32x4 (&acc)[2][2][4][2], const Unit& u, int wr, int wc, int fr, int fq) const {
        const int row0 = u.pm * BM + wr * 64 + fr; const int col0 = u.pn * HALF + wc * 32 + 8 * fq;
#pragma unroll
        for (int ai = 0; ai < 2; ++ai)
#pragma unroll
            for (int m = 0; m < 4; ++m) { bf16_t* rowp = O + (size_t)(row0 + ai * HALF + m * 16) * ldc + col0;
                float hv[8];
#pragma unroll
                for (int n = 0; n < 2; ++n)
#pragma unroll
                    for (int i = 0; i < 4; ++i) { const float gt = acc[ai][0][m][n][i], up = acc[ai][1][m][n][i];
                        const float sg = __builtin_amdgcn_rcpf(1.0f + __builtin_amdgcn_exp2f(-1.44269504089f * gt));
                        hv[n * 4 + i] = gt * sg * up; }
                u32x4 w; w.x = cvt_pk_bf16(hv[0], hv[1]); w.y = cvt_pk_bf16(hv[2], hv[3]); w.z = cvt_pk_bf16(hv[4], hv[5]); w.w = cvt_pk_bf16(hv[6], hv[7]);
                *(u32x4*)rowp = w; }
    }
};

template <class Epi, class Sched, bool ALIGN_EPI = false, bool SP2 = false>
__device__ __forceinline__ void gemm_phase(PG8_LAS unsigned char* lds, const Gemm g, const Sched& S, const Epi& E) {
    const int tid = threadIdx.x, wid = __builtin_amdgcn_readfirstlane(tid >> 6), lane = tid & 63, wr = wid >> 2, wc = wid & 3, fr = lane & 15, fq = lane >> 4;
    const int K = g.K, nt = K / BK;
    unsigned voffA[2], voffB[2];
#pragma unroll
    for (int i = 0; i < 2; ++i) { int R, C; stage_rc(tid * 16 + i * 8192, R, C); const int Rb = Epi::PERM ? ((R & ~31) + perm32(R & 31)) : R;
        voffA[i] = (unsigned)(R * K + C) * 2u; voffB[i] = (unsigned)(Rb * K + C) * 2u; }
    const size_t kstep = (size_t)(BK * 2);
    const size_t hstep = (size_t)HALF * K * 2;
    const size_t tstep = 2 * hstep;
    const unsigned ldsw = (unsigned)wid * 1024u;
    const int aoff = lds_byte(wr * 64 + fr, fq * 8), boff = lds_byte(wc * 32 + fr, fq * 8);
#define PG8_SA(b, h) (((b) * 2 + (h)) * HTB)
#define PG8_SB(b, h) ((4 + (b) * 2 + (h)) * HTB)
#define PG8_STAGE(bufoff, gbase, voff) do { _Pragma("unroll") for (int _i = 0; _i < 2; ++_i) \
        __builtin_amdgcn_global_load_lds((const unsigned*)((const char*)(gbase) + (voff)[_i]), (PG8_LAS unsigned*)(lds + (bufoff) + ldsw + _i * 8192), 16, 0, 0); } while (0)
#define PG8_LDA(dst, b, h) do { _Pragma("unroll") for (int m = 0; m < 4; ++m) _Pragma("unroll") for (int k = 0; k < 2; ++k) dst[m][k] = *(const PG8_LAS bf16x8*)(lds + PG8_SA(b, h) + aoff + m * 2048 + k * 1024); } while (0)
#define PG8_LDB(dst, b, h) do { _Pragma("unroll") for (int n = 0; n < 2; ++n) _Pragma("unroll") for (int k = 0; k < 2; ++k) dst[n][k] = *(const PG8_LAS bf16x8*)(lds + PG8_SB(b, h) + boff + n * 2048 + k * 1024); } while (0)
#define PG8_MMA(ai, bj, At, Bt) do { __builtin_amdgcn_s_setprio(1); _Pragma("unroll") for (int m = 0; m < 4; ++m) _Pragma("unroll") for (int n = 0; n < 2; ++n) _Pragma("unroll") for (int k = 0; k < 2; ++k) \
        acc[ai][bj][m][n] = __builtin_amdgcn_mfma_f32_16x16x32_bf16(Bt[n][k], At[m][k], acc[ai][bj][m][n], 0, 0, 0); __builtin_amdgcn_s_setprio(0); } while (0)
#define PG8_WAIT_V(n) asm volatile("s_waitcnt vmcnt(" #n ")" ::: "memory")
#define PG8_WAIT_L(n) asm volatile("s_waitcnt lgkmcnt(" #n ")" ::: "memory")
#define PG8_BAR __builtin_amdgcn_s_barrier()
#define PG8_SCHED __builtin_amdgcn_sched_barrier(0)
    Unit cur, nxt; int ui = 0;
    if (!S.next(0, cur)) return;
    f32x4 acc[2][2][4][2];
#pragma unroll
    for (int a = 0; a < 2; ++a)
#pragma unroll
        for (int b = 0; b < 2; ++b)
#pragma unroll
            for (int m = 0; m < 4; ++m)
#pragma unroll
                for (int n = 0; n < 2; ++n) acc[a][b][m][n] = (f32x4){0.f, 0.f, 0.f, 0.f};
    bf16x8 At[4][2], B0[2][2], B1[2][2];
    const char* cA = (const char*)g.A + (size_t)cur.pm * tstep; const char* cB = (const char*)g.Bt + (size_t)cur.pn * tstep;
    S.a_ready(cur);
    if constexpr (SP2) {
        PG8_STAGE(PG8_SB(0, 0), cB, voffB); PG8_STAGE(PG8_SB(0, 1), cB + hstep, voffB); PG8_STAGE(PG8_SA(0, 0), cA, voffA); PG8_STAGE(PG8_SA(0, 1), cA + hstep, voffA);
        if (wr == 1) PG8_BAR;
        PG8_WAIT_V(2); PG8_BAR;
        PG8_STAGE(PG8_SB(1, 0), cB + kstep, voffB); PG8_STAGE(PG8_SA(1, 0), cA + kstep, voffA); PG8_STAGE(PG8_SB(1, 1), cB + hstep + kstep, voffB);
        PG8_WAIT_V(6); PG8_BAR;
    } else {
        PG8_STAGE(PG8_SB(0, 0), cB, voffB); PG8_STAGE(PG8_SA(0, 0), cA, voffA); PG8_STAGE(PG8_SB(0, 1), cB + hstep, voffB); PG8_STAGE(PG8_SA(0, 1), cA + hstep, voffA);
        if (wr == 1) PG8_BAR;
        PG8_WAIT_V(4); PG8_BAR;
        PG8_STAGE(PG8_SB(1, 0), cB + kstep, voffB); PG8_STAGE(PG8_SA(1, 0), cA + kstep, voffA); PG8_STAGE(PG8_SB(1, 1), cB + hstep + kstep, voffB);
        PG8_WAIT_V(6); PG8_BAR;
    }
    for (;;) {
        const bool has_next = S.next(ui + 1, nxt);
        const char* nA = has_next ? (const char*)g.A + (size_t)nxt.pm * tstep : cA; const char* nB = has_next ? (const char*)g.Bt + (size_t)nxt.pn * tstep : cB;
        for (int t = 0; t < nt; t += 2) {
            const bool last = (t == nt - 2);
            const char* a1 = cA + (size_t)(t + 1) * kstep;
            const char* a2 = last ? nA : cA + (size_t)(t + 2) * kstep; const char* b2 = last ? nB : cB + (size_t)(t + 2) * kstep;
            const char* a3 = a2 + kstep; const char* b3 = b2 + kstep;
            if (last && has_next) S.a_ready(nxt);
            if constexpr (SP2) {
            PG8_LDB(B0, 0, 0); PG8_LDB(B1, 0, 1); PG8_SCHED; PG8_LDA(At, 0, 0); PG8_STAGE(PG8_SA(1, 1), a1 + hstep, voffA);
            PG8_WAIT_V(8); PG8_WAIT_L(0); PG8_BAR; PG8_MMA(0, 0, At, B0); PG8_MMA(0, 1, At, B1); PG8_BAR; PG8_SCHED;
            PG8_LDA(At, 0, 1); PG8_STAGE(PG8_SB(0, 0), b2, voffB); PG8_STAGE(PG8_SB(0, 1), b2 + hstep, voffB); PG8_STAGE(PG8_SA(0, 0), a2, voffA);
            PG8_WAIT_V(8); PG8_WAIT_L(0); PG8_BAR; PG8_MMA(1, 0, At, B0); PG8_MMA(1, 1, At, B1); PG8_BAR; PG8_SCHED;
            PG8_LDB(B0, 1, 0); PG8_LDB(B1, 1, 1); PG8_SCHED; PG8_LDA(At, 1, 0); PG8_STAGE(PG8_SA(0, 1), a2 + hstep, voffA);
            PG8_WAIT_V(8); PG8_WAIT_L(0); PG8_BAR; PG8_MMA(0, 0, At, B0); PG8_MMA(0, 1, At, B1); PG8_BAR; PG8_SCHED;
            PG8_LDA(At, 1, 1); PG8_STAGE(PG8_SB(1, 0), b3, voffB); PG8_STAGE(PG8_SB(1, 1), b3 + hstep, voffB); PG8_STAGE(PG8_SA(1, 0), a3, voffA);
            PG8_WAIT_V(8); PG8_WAIT_L(0); PG8_BAR; PG8_MMA(1, 0, At, B0); PG8_MMA(1, 1, At, B1); PG8_BAR; PG8_SCHED;
            } else {
            PG8_LDB(B0, 0, 0); PG8_SCHED; PG8_LDA(At, 0, 0); PG8_STAGE(PG8_SA(1, 1), a1 + hstep, voffA);
            PG8_WAIT_L(8); PG8_BAR; PG8_WAIT_L(0); PG8_MMA(0, 0, At, B0); PG8_BAR; PG8_SCHED;
            PG8_LDB(B1, 0, 1); PG8_STAGE(PG8_SB(0, 0), b2, voffB);
            PG8_BAR; PG8_WAIT_L(0); PG8_MMA(0, 1, At, B1); PG8_BAR;
            PG8_LDA(At, 0, 1); PG8_STAGE(PG8_SA(0, 0), a2, voffA);
            PG8_BAR; PG8_WAIT_L(0); PG8_MMA(1, 0, At, B0); PG8_BAR; PG8_SCHED;
            PG8_STAGE(PG8_SB(0, 1), b2 + hstep, voffB);
            PG8_WAIT_V(6); PG8_BAR; PG8_MMA(1, 1, At, B1); PG8_BAR;
            PG8_LDB(B0, 1, 0); PG8_SCHED; PG8_LDA(At, 1, 0); PG8_STAGE(PG8_SA(0, 1), a2 + hstep, voffA);
            PG8_WAIT_L(8); PG8_BAR; PG8_WAIT_L(0); PG8_MMA(0, 0, At, B0); PG8_BAR; PG8_SCHED;
            PG8_LDB(B1, 1, 1); PG8_STAGE(PG8_SB(1, 0), b3, voffB);
            PG8_BAR; PG8_WAIT_L(0); PG8_MMA(0, 1, At, B1); PG8_BAR;
            PG8_LDA(At, 1, 1); PG8_STAGE(PG8_SA(1, 0), a3, voffA);
            PG8_BAR; PG8_WAIT_L(0); PG8_MMA(1, 0, At, B0); PG8_BAR; PG8_SCHED;
            PG8_STAGE(PG8_SB(1, 1), b3 + hstep, voffB);
            PG8_WAIT_V(6); PG8_BAR; PG8_MMA(1, 1, At, B1); PG8_BAR;
            }
        }
        if constexpr (ALIGN_EPI) { if (wr == 0) PG8_BAR; }
        if constexpr (!Epi::AFTER_DRAIN) { E(acc, cur, wr, wc, fr, fq); S.done(cur); }
        if (!has_next) break;
#pragma unroll
        for (int a = 0; a < 2; ++a)
#pragma unroll
            for (int b = 0; b < 2; ++b)
#pragma unroll
                for (int m = 0; m < 4; ++m)
#pragma unroll
                    for (int n = 0; n < 2; ++n) acc[a][b][m][n] = (f32x4){0.f, 0.f, 0.f, 0.f};
        cur = nxt; cA = nA; cB = nB; ++ui;
        if constexpr (ALIGN_EPI) { if (wr == 1) PG8_BAR; }
    }
    PG8_WAIT_V(0);
    if constexpr (!ALIGN_EPI) { if (wr == 0) PG8_BAR; }
    PG8_BAR;
    if constexpr (Epi::AFTER_DRAIN) { E.fused(acc, cur, wr, wc, fr, fq, lds, wid, lane); S.done(cur); }
#undef PG8_SA
#undef PG8_SB
#undef PG8_STAGE
#undef PG8_LDA
#undef PG8_LDB
#undef PG8_MMA
#undef PG8_WAIT_V
#undef PG8_WAIT_L
#undef PG8_BAR
#undef PG8_SCHED
}
}

namespace cg = cooperative_groups;
#define GAS __attribute__((address_space(1)))
#define LAS __attribute__((address_space(3)))
typedef unsigned short bf16;
typedef unsigned v4u __attribute__((ext_vector_type(4)));
typedef unsigned v2u __attribute__((ext_vector_type(2)));
typedef float f32x4 __attribute__((ext_vector_type(4)));
typedef short bf16x8 __attribute__((ext_vector_type(8)));
typedef short s16x4 __attribute__((ext_vector_type(4)));

constexpr int NWAVES = 8, NTHREADS = NWAVES * 64;
constexpr int S = 16384, DM = 2048, INW = 4352, DFF = 5632, NUP = 2 * DFF;
constexpr int QA_OFF = 0, KA_OFF = 1024, VA_OFF = 2048, QB_OFF = 3072, KB_OFF = 4096, VB_OFF = 4224;
constexpr float ALPHA = 1.189207115002721f;
constexpr float LN_EPS = 1e-5f, RMS_EPS = 1e-6f;
constexpr int LDS_BYTES = 131072;

constexpr size_t MiB = 1u << 20;
constexpr size_t WS_SSQ = 0;
constexpr size_t WS_COSA = 1 * MiB, WS_SINA = 5 * MiB, WS_COSB = 9 * MiB, WS_SINB = 11 * MiB;
constexpr size_t WS_WI = 16 * MiB, WS_WO = 33 * MiB, WS_WU = 41 * MiB, WS_WD = 85 * MiB;
constexpr size_t WS_XB = 108 * MiB;
constexpr size_t WS_PROJ = 172 * MiB;
constexpr size_t WS_Y = 308 * MiB;
constexpr size_t WS_H = 172 * MiB;
constexpr size_t WS_END = 372 * MiB;
static_assert(WS_WI + (size_t)INW * DM * 2 <= WS_WO && WS_WO + (size_t)DM * DM * 2 <= WS_WU && WS_WU + (size_t)NUP * DM * 2 <= WS_WD && WS_WD + (size_t)DM * DFF * 2 <= WS_XB, "ws map (weights)");
static_assert(WS_XB + (size_t)S * DM * 2 <= WS_PROJ && WS_PROJ + (size_t)S * INW * 2 <= WS_Y && WS_Y + (size_t)S * DM * 2 <= WS_END && WS_H + (size_t)S * DFF * 2 <= WS_END, "ws map (activations)");

__device__ __forceinline__ unsigned f2bf(float f) { unsigned u = __builtin_bit_cast(unsigned, f); return (u + 0x7fffu + ((u >> 16) & 1u)) >> 16; }
__device__ __forceinline__ unsigned pk2(float lo, float hi) { return f2bf(lo) | (f2bf(hi) << 16); }
__device__ __forceinline__ float bflo(unsigned w) { return __builtin_bit_cast(float, w << 16); }
__device__ __forceinline__ float bfhi(unsigned w) { return __builtin_bit_cast(float, w & 0xffff0000u); }
#define LDS_WAIT() asm volatile("s_waitcnt lgkmcnt(0)" ::: "memory")

__device__ __forceinline__ float wave_sum(float v) {
#pragma unroll
    for (int o = 1; o < 64; o <<= 1) v += __shfl_xor(v, o);
    return v;
}

__device__ __forceinline__ void p0_transpose_item(const float* W, int K, int N, bf16* WT, int k0, int n0, int drow0, LAS float* scr, int lane) {
#pragma unroll 8
    for (int i = 0; i < 32; ++i) { const int kk = 2 * i + (lane >> 5); scr[kk * 33 + (lane & 31)] = W[(size_t)(k0 + kk) * N + n0 + (lane & 31)]; }
    LDS_WAIT(); asm volatile("" ::: "memory");
    const int c = lane & 7;
#pragma unroll
    for (int j = 0; j < 4; ++j) { const int n = (lane >> 3) + 8 * j; const LAS float* s = scr + (8 * c) * 33 + n;
        v4u o; o.x = pk2(s[0 * 33], s[1 * 33]); o.y = pk2(s[2 * 33], s[3 * 33]); o.z = pk2(s[4 * 33], s[5 * 33]); o.w = pk2(s[6 * 33], s[7 * 33]);
        *(v4u*)(WT + (size_t)(drow0 + n) * K + k0 + 8 * c) = o; }
    LDS_WAIT(); asm volatile("" ::: "memory");
}

struct Args { const float* in[13]; float* out; unsigned char* ws; };

__device__ __forceinline__ void phase_prologue(const Args& a, LAS unsigned char* lds, int gw, int NGW, int lane, int wave) {
    unsigned char* ws = a.ws;
    LAS float* scr = (LAS float*)(lds + wave * 16384);
    const float* w_in = a.in[1]; const float* w_out = a.in[6]; const float* w_up = a.in[9]; const float* w_down = a.in[10];
    bf16* Wi = (bf16*)(ws + WS_WI); bf16* Wo = (bf16*)(ws + WS_WO); bf16* Wu = (bf16*)(ws + WS_WU); bf16* Wd = (bf16*)(ws + WS_WD);
    constexpr int I_IN = (DM / 64) * (INW / 32), I_OUT = (DM / 64) * (DM / 32), I_UP = (DM / 64) * (NUP / 32), I_DN = (DFF / 64) * (DM / 32);
    constexpr int NITEMS = I_IN + I_OUT + I_UP + I_DN;
    for (int it = gw; it < NITEMS; it += NGW) {
        int r = it;
        if (r < I_IN) { const int nb = INW / 32, kb = r / nb, n0 = (r % nb) * 32; p0_transpose_item(w_in, DM, INW, Wi, kb * 64, n0, n0, scr, lane); continue; } r -= I_IN;
        if (r < I_OUT) { const int nb = DM / 32, kb = r / nb, n0 = (r % nb) * 32; p0_transpose_item(w_out, DM, DM, Wo, kb * 64, n0, n0, scr, lane); continue; } r -= I_OUT;
        if (r < I_UP) { const int nb = NUP / 32, kb = r / nb, n0 = (r % nb) * 32; const int half = n0 / DFF, rem = n0 % DFF;
            p0_transpose_item(w_up, DM, NUP, Wu, kb * 64, n0, 256 * (rem / 128) + 128 * half + (rem % 128), scr, lane); continue; } r -= I_UP;
        { const int nb = DM / 32, kb = r / nb, n0 = (r % nb) * 32; p0_transpose_item(w_down, DFF, DM, Wd, kb * 64, n0, n0, scr, lane); }
    }
    const int gt = gw * 64 + lane, NGT = NGW * 64;
    { const f32x4* x4 = (const f32x4*)a.in[0]; v4u* xb = (v4u*)(ws + WS_XB);
      for (int i = gt; i < S * DM / 8; i += NGT) { const f32x4 p = x4[2 * i], q = x4[2 * i + 1]; v4u o; o.x = pk2(p[0], p[1]); o.y = pk2(p[2], p[3]); o.z = pk2(q[0], q[1]); o.w = pk2(q[2], q[3]); xb[i] = o; } }
    { float* cA = (float*)(ws + WS_COSA); float* sA = (float*)(ws + WS_SINA); float* cB = (float*)(ws + WS_COSB); float* sB = (float*)(ws + WS_SINB);
      for (int i = gt; i < S * 96; i += NGT) { const int pos = i / 96, j = i % 96; const bool isA = j < 64; const int jj = isA ? j : j - 64;
          const double e = -(double)jj * (isA ? (13.287712379549449 / 64.0) : (13.287712379549449 / 32.0));
          const double inv = exp2(e); double turns = (double)pos * inv * 0.15915494309189535; turns -= floor(turns);
          const float fr = (float)turns; const float cv = __builtin_amdgcn_cosf(fr), sv = __builtin_amdgcn_sinf(fr);
          if (isA) { cA[pos * 64 + jj] = cv; sA[pos * 64 + jj] = sv; } else { cB[pos * 32 + jj] = cv; sB[pos * 32 + jj] = sv; } } }
    { float* ssq = (float*)(ws + WS_SSQ); for (int i = gt; i < S * 2; i += NGT) ssq[i] = 0.f; }
}

__device__ __forceinline__ void phase_rope(const Args& a, int gt, int NGT) {
    unsigned char* ws = a.ws; bf16* proj = (bf16*)(ws + WS_PROJ);
    const float* cA = (const float*)(ws + WS_COSA); const float* sA = (const float*)(ws + WS_SINA); const float* cB = (const float*)(ws + WS_COSB); const float* sB = (const float*)(ws + WS_SINB);
    for (int it = gt; it < S * 200; it += NGT) {
        const int pos = it / 200, i = it % 200; int col, pcol; const float *ct, *st;
        if (i < 128) { col = (i >> 3) * 128 + (i & 7) * 8; pcol = col + 64; ct = cA + pos * 64 + (i & 7) * 8; st = sA + pos * 64 + (i & 7) * 8; }
        else { const int j = i - 128; col = QB_OFF + (j >> 2) * 64 + (j & 3) * 8; pcol = col + 32; ct = cB + pos * 32 + (j & 3) * 8; st = sB + pos * 32 + (j & 3) * 8; }
        v4u* p1 = (v4u*)(proj + (size_t)pos * INW + col); v4u* p2 = (v4u*)(proj + (size_t)pos * INW + pcol);
        const v4u u1 = *p1, u2 = *p2; const f32x4 c0 = *(const f32x4*)ct, c1 = *(const f32x4*)(ct + 4), s0 = *(const f32x4*)st, s1 = *(const f32x4*)(st + 4);
        v4u o1, o2;
#pragma unroll
        for (int e = 0; e < 4; ++e) { const float xa = bflo(u1[e]), xb = bfhi(u1[e]), ya = bflo(u2[e]), yb = bfhi(u2[e]);
            const float ca = e < 2 ? c0[2 * e] : c1[2 * e - 4], cb = e < 2 ? c0[2 * e + 1] : c1[2 * e - 3], sa = e < 2 ? s0[2 * e] : s1[2 * e - 4], sb = e < 2 ? s0[2 * e + 1] : s1[2 * e - 3];
            o1[e] = pk2(xa * ca - ya * sa, xb * cb - yb * sb); o2[e] = pk2(ya * ca + xa * sa, yb * cb + xb * sb); }
        *p1 = o1; *p2 = o2;
    }
}

namespace att {
constexpr int VROW = 288, VBUF = 32 * VROW;
__device__ __forceinline__ s16x4 vtr(const LAS unsigned char* p) { typedef short v4i16_t __attribute__((ext_vector_type(4)));
    return __builtin_bit_cast(s16x4, __builtin_amdgcn_ds_read_tr16_b64_v4i16((LAS v4i16_t*)p)); }
__device__ __forceinline__ unsigned cvtpk(float lo, float hi) { unsigned r; asm volatile("v_cvt_pk_bf16_f32 %0, %1, %2" : "=v"(r) : "v"(lo), "v"(hi)); return r; }

template <int D> struct KF { bf16x8 k[2][D / 32]; };
template <int D> struct VF { bf16x8 v[D / 16]; };

template <int D>
__device__ __forceinline__ void load_k(KF<D>& t, const bf16* kcol, int kbase, int dil, int b, int lane) {
    const int c = lane & 15;
#pragma unroll
    for (int tt = 0; tt < 2; ++tt) { int kp = kbase + dil * (32 * b + 16 * tt + c); kp = kp < 0 ? 0 : (kp > S - 1 ? S - 1 : kp); const bf16* rp = kcol + (size_t)kp * INW;
#pragma unroll
        for (int ks = 0; ks < D / 32; ++ks) t.k[tt][ks] = *(const bf16x8*)(rp + 32 * ks); }
}
template <int D>
__device__ __forceinline__ void load_v(VF<D>& t, const bf16* vcol, int kbase, int dil, int b, int lane) {
    constexpr int CPR = D / 8;
#pragma unroll
    for (int i = 0; i < D / 16; ++i) { const int n = lane + 64 * i, row = n / CPR, ch = n % CPR; int kp = kbase + dil * (32 * b + row); kp = kp < 0 ? 0 : (kp > S - 1 ? S - 1 : kp);
        t.v[i] = *(const bf16x8*)(vcol + (size_t)kp * INW + 8 * ch); }
}

template <int D>
__device__ __forceinline__ void span(f32x4 (&o)[D / 16], float& m, float& l, const bf16x8 (&qf)[D / 32], const bf16* kcol, const bf16* vcol,
                                     int kbase, int dil, int nblk, int tqrel, int maxdist, float sc, LAS unsigned char* vl, int lane) {
    const int g = lane >> 4, q4 = (lane & 15) >> 2, p4 = lane & 3;
    constexpr int CPR = D / 8;
    KF<D> cur, nxt; VF<D> vv;
    load_k<D>(cur, kcol, kbase, dil, 0, lane); load_v<D>(vv, vcol, kbase, dil, 0, lane);
    for (int b = 0; b < nblk; ++b) {
#pragma unroll
        for (int i = 0; i < D / 16; ++i) { const int n = lane + 64 * i, row = n / CPR, ch = n % CPR; *(LAS bf16x8*)(vl + row * VROW + ch * 16) = vv.v[i]; }
        if (b + 1 < nblk) { load_k<D>(nxt, kcol, kbase, dil, b + 1, lane); load_v<D>(vv, vcol, kbase, dil, b + 1, lane); }
        f32x4 a0 = {0.f, 0.f, 0.f, 0.f}, a1 = {0.f, 0.f, 0.f, 0.f};
#pragma unroll
        for (int ks = 0; ks < D / 32; ++ks) { a0 = __builtin_amdgcn_mfma_f32_16x16x32_bf16(cur.k[0][ks], qf[ks], a0, 0, 0, 0); a1 = __builtin_amdgcn_mfma_f32_16x16x32_bf16(cur.k[1][ks], qf[ks], a1, 0, 0, 0); }
        float s[8];
#pragma unroll
        for (int e = 0; e < 8; ++e) { const int jj = 32 * b + 16 * (e >> 2) + 4 * g + (e & 3); const int dist = tqrel - dil * jj; const bool ok = ((unsigned)dist <= (unsigned)maxdist) && (kbase + dil * jj >= 0);
            const float v = (e < 4 ? a0[e & 3] : a1[e & 3]) * sc; s[e] = ok ? v : -INFINITY; }
        float ml = fmaxf(fmaxf(fmaxf(s[0], s[1]), fmaxf(s[2], s[3])), fmaxf(fmaxf(s[4], s[5]), fmaxf(s[6], s[7])));
        ml = fmaxf(ml, __shfl_xor(ml, 16)); ml = fmaxf(ml, __shfl_xor(ml, 32));
        const float mn = fmaxf(m, ml); const float ms = (mn == -INFINITY) ? 0.f : mn;
        const float alpha = __builtin_amdgcn_exp2f(m - ms);
        float p[8], ps = 0.f;
#pragma unroll
        for (int e = 0; e < 8; ++e) { p[e] = __builtin_amdgcn_exp2f(s[e] - ms); ps += p[e]; }
        l = l * alpha + ps; m = mn;
#pragma unroll
        for (int nt = 0; nt < D / 16; ++nt) o[nt] = o[nt] * alpha;
        v4u pw; pw.x = cvtpk(p[0], p[1]); pw.y = cvtpk(p[2], p[3]); pw.z = cvtpk(p[4], p[5]); pw.w = cvtpk(p[6], p[7]);
        const bf16x8 pf = __builtin_bit_cast(bf16x8, pw);
#pragma unroll
        for (int nt = 0; nt < D / 16; ++nt) {
            const s16x4 r1 = vtr(vl + (4 * g + q4) * VROW + (16 * nt + 4 * p4) * 2), r2 = vtr(vl + (16 + 4 * g + q4) * VROW + (16 * nt + 4 * p4) * 2);
            bf16x8 vf; vf[0] = r1[0]; vf[1] = r1[1]; vf[2] = r1[2]; vf[3] = r1[3]; vf[4] = r2[0]; vf[5] = r2[1]; vf[6] = r2[2]; vf[7] = r2[3];
            o[nt] = __builtin_amdgcn_mfma_f32_16x16x32_bf16(vf, pf, o[nt], 0, 0, 0);
        }
        if (b + 1 < nblk) cur = nxt;
    }
}

template <int D>
__device__ __forceinline__ void finish(const f32x4 (&o)[D / 16], float ltot, bf16* yrow  , float* ssqp, int lane) {
    const float inv = 1.0f / ltot; float sq = 0.f;
#pragma unroll
    for (int nt = 0; nt < D / 16; ++nt) { const f32x4 v = o[nt] * inv; sq += (v[0] * v[0] + v[1] * v[1]) + (v[2] * v[2] + v[3] * v[3]);
        v2u w; w.x = cvtpk(v[0], v[1]); w.y = cvtpk(v[2], v[3]); *(v2u*)(yrow + 16 * nt) = w; }
    sq += __shfl_xor(sq, 16); sq += __shfl_xor(sq, 32);
    if ((lane >> 4) == 0) atomicAdd(ssqp, sq);
}
}

__device__ __forceinline__ void phase_attention(const Args& a, LAS unsigned char* lds, int gw, int NGW, int lane, int wave) {
    unsigned char* ws = a.ws; const bf16* proj = (const bf16*)(ws + WS_PROJ); bf16* Y = (bf16*)(ws + WS_Y); float* ssq = (float*)(ws + WS_SSQ);
    const float* sinks = a.in[3];
    LAS unsigned char* vl = lds + wave * att::VBUF;
    const int c = lane & 15, g = lane >> 4;
    for (int t = gw; t < 8 * 64 * 16; t += NGW) {
        const int r = t & 15, mb = (t >> 4) & 63, h = t >> 10; const int t0 = r + 256 * mb, tq = t0 + 16 * c;
        bf16x8 qf[4];
#pragma unroll
        for (int ks = 0; ks < 4; ++ks) qf[ks] = *(const bf16x8*)(proj + (size_t)tq * INW + QA_OFF + h * 128 + 32 * ks + 8 * g);
        f32x4 o[8];
#pragma unroll
        for (int nt = 0; nt < 8; ++nt) o[nt] = (f32x4){0.f, 0.f, 0.f, 0.f};
        float m = -INFINITY, l = 0.f;
        const bf16* kcol = proj + KA_OFF + h * 128 + 8 * g; const bf16* vcol = proj + VA_OFF + h * 128;
        const float sc = 1.44269504089f * 0.08838834764831845f;
        att::span<128>(o, m, l, qf, kcol, vcol, t0 - 128, 1, 12, 16 * c + 128, 128, sc, vl, lane);
        att::span<128>(o, m, l, qf, kcol, vcol, t0 - 512, 4, 6, 16 * c + 512, 512, sc, vl, lane);
        att::span<128>(o, m, l, qf, kcol, vcol, t0 - 2048, 16, 5, 16 * c + 2048, 2048, sc, vl, lane);
        float lt = l; lt += __shfl_xor(lt, 16); lt += __shfl_xor(lt, 32);
        att::finish<128>(o, lt, Y + (size_t)tq * DM + h * 128 + 4 * g, ssq + 2 * tq, lane);
    }
    for (int t = gw; t < 16 * 1024; t += NGW) {
        const int hl = t & 7, pb = (t >> 3) & 1023, kvh = t >> 13, hq = kvh * 8 + hl; const int tq = 16 * pb + c;
        bf16x8 qf[2];
#pragma unroll
        for (int ks = 0; ks < 2; ++ks) qf[ks] = *(const bf16x8*)(proj + (size_t)tq * INW + QB_OFF + hq * 64 + 32 * ks + 8 * g);
        f32x4 o[4];
#pragma unroll
        for (int nt = 0; nt < 4; ++nt) o[nt] = (f32x4){0.f, 0.f, 0.f, 0.f};
        float m = -INFINITY, l = 0.f;
        const bf16* kcol = proj + KB_OFF + kvh * 64 + 8 * g; const bf16* vcol = proj + VB_OFF + kvh * 64;
        att::span<64>(o, m, l, qf, kcol, vcol, 16 * pb - 128, 1, 5, c + 128, 127, 1.44269504089f * 0.125f, vl, lane);
        float lt = l; lt += __shfl_xor(lt, 16); lt += __shfl_xor(lt, 32);
        lt += __builtin_amdgcn_exp2f(sinks[hq] * 1.44269504089f - m);
        att::finish<64>(o, lt, Y + (size_t)tq * DM + 1024 + hq * 64 + 4 * g, ssq + 2 * tq + 1, lane);
    }
}

__device__ __forceinline__ void phase_rms(const Args& a, int gt, int NGT) {
    unsigned char* ws = a.ws; v4u* Y = (v4u*)(ws + WS_Y); const float* ssq = (const float*)(ws + WS_SSQ);
    const float* ga = a.in[4]; const float* gb = a.in[5];
    for (int i = gt; i < S * DM / 8; i += NGT) { const int pos = i >> 8, c8 = (i & 255) * 8; const int grp = c8 >> 10;
        const float rs = 1.0f / sqrtf(ssq[2 * pos + grp] * (1.0f / 1024.0f) + RMS_EPS);
        const float* gp = grp ? gb + (c8 - 1024) : ga + c8; const f32x4 g0 = *(const f32x4*)gp, g1 = *(const f32x4*)(gp + 4);
        const v4u u = Y[i]; v4u o;
        o.x = pk2(bflo(u.x) * rs * g0[0], bfhi(u.x) * rs * g0[1]); o.y = pk2(bflo(u.y) * rs * g0[2], bfhi(u.y) * rs * g0[3]);
        o.z = pk2(bflo(u.z) * rs * g1[0], bfhi(u.z) * rs * g1[1]); o.w = pk2(bflo(u.w) * rs * g1[2], bfhi(u.w) * rs * g1[3]);
        Y[i] = o; }
}

__device__ __forceinline__ void phase_ln(float* buf, const float* gam, const float* bet, bf16* xb, int gw, int NGW, int lane) {
    for (int row = gw; row < S; row += NGW) {
        f32x4* xr = (f32x4*)(buf + (size_t)row * DM) + lane;
        f32x4 v[8]; float s = 0.f;
#pragma unroll
        for (int j = 0; j < 8; ++j) { v[j] = xr[64 * j]; s += (v[j][0] + v[j][1]) + (v[j][2] + v[j][3]); }
        const float mean = wave_sum(s) * (1.f / DM); float s2 = 0.f;
#pragma unroll
        for (int j = 0; j < 8; ++j) { v[j] = v[j] - mean; s2 += (v[j][0] * v[j][0] + v[j][1] * v[j][1]) + (v[j][2] * v[j][2] + v[j][3] * v[j][3]); }
        const float rstd = 1.f / sqrtf(wave_sum(s2) * (1.f / DM) + LN_EPS);
#pragma unroll
        for (int j = 0; j < 8; ++j) { const f32x4 gg = *((const f32x4*)gam + lane + 64 * j), bb = *((const f32x4*)bet + lane + 64 * j);
            const f32x4 ov = v[j] * rstd * gg + bb; xr[64 * j] = ov;
            if (xb) { v2u w; w.x = pk2(ov[0], ov[1]); w.y = pk2(ov[2], ov[3]); *((v2u*)(xb + (size_t)row * DM) + lane + 64 * j) = w; } }
    }
}

__global__ void __launch_bounds__(NTHREADS, 2) hymba_fwd(Args args) {
    extern __shared__ __attribute__((aligned(16))) unsigned char lds_raw[];
    LAS unsigned char* lds = (LAS unsigned char*)lds_raw;
    cg::grid_group grid = cg::this_grid();
    const int tid = threadIdx.x, lane = tid & 63, wave = __builtin_amdgcn_readfirstlane(tid >> 6);
    const int G = gridDim.x, gw = blockIdx.x * NWAVES + wave, NGW = G * NWAVES, gt = blockIdx.x * NTHREADS + tid, NGT = G * NTHREADS;
    unsigned char* ws = args.ws;
    bf16* Wi = (bf16*)(ws + WS_WI); bf16* Wo = (bf16*)(ws + WS_WO); bf16* Wu = (bf16*)(ws + WS_WU); bf16* Wd = (bf16*)(ws + WS_WD);
    bf16* XB = (bf16*)(ws + WS_XB); bf16* PROJ = (bf16*)(ws + WS_PROJ); bf16* Y = (bf16*)(ws + WS_Y); bf16* H = (bf16*)(ws + WS_H);

    phase_prologue(args, lds, gw, NGW, lane, wave);
    grid.sync();
    {
        pg8::Gemm g{XB, Wi, S, INW, DM}; pg8::StaticOrder So; So.init(S, INW, G, (int)blockIdx.x);
        pg8::EpiBf16 E{PROJ, INW, args.in[2]};
        pg8::gemm_phase<pg8::EpiBf16, pg8::StaticOrder, true, true>(lds, g, So, E);
    }
    grid.sync();
    phase_rope(args, gt, NGT);
    grid.sync();
    phase_attention(args, lds, gw, NGW, lane, wave);
    grid.sync();
    phase_rms(args, gt, NGT);
    grid.sync();
    {
        pg8::Gemm g{Y, Wo, S, DM, DM}; pg8::StaticOrder So; So.init(S, DM, G, (int)blockIdx.x);
        pg8::EpiRes E{args.in[0], args.out, DM, ALPHA};
        pg8::gemm_phase<pg8::EpiRes, pg8::StaticOrder, true, true>(lds, g, So, E);
    }
    grid.sync();
    phase_ln(args.out, args.in[7], args.in[8], XB, gw, NGW, lane);
    grid.sync();
    {
        pg8::Gemm g{XB, Wu, S, NUP, DM}; pg8::StaticOrder So; So.init(S, NUP, G, (int)blockIdx.x);
        pg8::EpiSwiglu E{H, DFF};
        pg8::gemm_phase<pg8::EpiSwiglu, pg8::StaticOrder, true, true>(lds, g, So, E);
    }
    grid.sync();
    {
        pg8::Gemm g{H, Wd, S, DM, DFF}; pg8::StaticOrder So; So.init(S, DM, G, (int)blockIdx.x);
        pg8::EpiRes E{args.out, args.out, DM, ALPHA};
        pg8::gemm_phase<pg8::EpiRes, pg8::StaticOrder, true, true>(lds, g, So, E);
    }
    grid.sync();
    phase_ln(args.out, args.in[11], args.in[12], nullptr, gw, NGW, lane);
}

extern "C" void kernel_launch(void* const* d_in, const int* in_sizes, int n_in, void* d_out, int out_size, void* d_ws, size_t ws_size, hipStream_t stream) {
    static int grid = 0;
    if (grid == 0) {
        if (n_in != 13 || in_sizes[0] != S * DM || out_size != S * DM || ws_size < WS_END) { fprintf(stderr, "kernel_launch: unexpected shapes (n_in %d, in0 %d, out %d, ws %zu)\n", n_in, n_in > 0 ? in_sizes[0] : -1, out_size, ws_size); grid = -1; return; }
        int dev = 0, cus = 0, per_cu = 0;
        if (hipGetDevice(&dev) != hipSuccess || hipDeviceGetAttribute(&cus, hipDeviceAttributeMultiprocessorCount, dev) != hipSuccess) { grid = -1; return; }
        if (hipFuncSetAttribute((const void*)hymba_fwd, hipFuncAttributeMaxDynamicSharedMemorySize, LDS_BYTES) != hipSuccess) { fprintf(stderr, "kernel_launch: hipFuncSetAttribute failed\n"); grid = -1; return; }
        if (hipOccupancyMaxActiveBlocksPerMultiprocessor(&per_cu, (const void*)hymba_fwd, NTHREADS, LDS_BYTES) != hipSuccess || per_cu < 1) { fprintf(stderr, "kernel_launch: occupancy query gave %d\n", per_cu); per_cu = 1; }
        (void)hipGetLastError();
        grid = cus * per_cu;
    }
    if (grid < 0) return;
    Args a{};
    for (int i = 0; i < 13; ++i) a.in[i] = (const float*)d_in[i];
    a.out = (float*)d_out; a.ws = (unsigned char*)d_ws;
    void* kargs[] = {&a};
    hipError_t e = hipLaunchCooperativeKernel((const void*)hymba_fwd, dim3(grid), dim3(NTHREADS), kargs, LDS_BYTES, stream);
    if (e != hipSuccess) fprintf(stderr, "cooperative launch failed: %s (grid %d)\n", hipGetErrorString(e), grid);
}
```

```cpp
#include <hip/hip_runtime.h>
#include <hip/hip_cooperative_groups.h>
#include <cstdio>
#include <cstdint>
#include <cmath>
namespace pg8 {
#define PG8_LAS __attribute__((address_space(3)))
typedef unsigned short bf16_t;
typedef short bf16x8 __attribute__((ext_vector_type(8)));
typedef float f32x4 __attribute__((ext_vector_type(4)));
typedef unsigned u32x4 __attribute__((ext_vector_type(4)));
constexpr int BM = 256, BK = 64, HALF = 128, HTB = HALF * BK * 2  , STAGE_BYTES = 8 * HTB, NXCD = 8, WGM = 8;

__host__ __device__ __forceinline__ int lds_byte(int r, int c) { const int st = (r >> 4) * 2 + (c >> 5), rr = r & 15, cc = c & 31, ob = rr * 64 + cc * 2; return st * 1024 + (ob ^ (((ob >> 9) & 1) << 5)); }
__host__ __device__ __forceinline__ void stage_rc(int b, int& R, int& C) { const int st = b / 1024, sb = b % 1024, swz = sb ^ (((sb >> 9) & 1) << 5); R = (st >> 1) * 16 + swz / 64; C = (st & 1) * 32 + (swz % 64) / 2; }
__host__ __device__ __forceinline__ int perm32(int rho) { const int n = rho >> 4, i = rho & 15; return 8 * (i >> 2) + 4 * n + (i & 3); }

struct Unit { int pm, pn; };
struct Gemm { const bf16_t* A; const bf16_t* Bt; int M, N, K; };

struct StaticOrder {
    int nM, nN, nwg, G, c;
    __host__ __device__ void init(int M, int N, int G_, int c_) { nM = M / BM; nN = N / BM; nwg = nM * nN; G = G_; c = c_; }
    __host__ __device__ bool next(int i, Unit& u) const {
        const long L = (long)i * G + c; if (L >= nwg) return false;
        int wgid = (int)L; { const int q = nwg / NXCD, r = nwg % NXCD, xcd = wgid % NXCD, off = wgid / NXCD; wgid = (xcd < r ? xcd * (q + 1) : r * (q + 1) + (xcd - r) * q) + off; }
        const int nig = WGM * nN, gid = wgid / nig, fm = gid * WGM, gsz = (nM - fm) < WGM ? (nM - fm) : WGM;
        u.pm = fm + ((wgid % nig) % gsz); u.pn = (wgid % nig) / gsz; return true;
    }
    __device__ __forceinline__ void a_ready(const Unit&) const {}
    __device__ __forceinline__ void done(const Unit&) const {}
};

__device__ __forceinline__ unsigned cvt_pk_bf16(float lo, float hi) { unsigned r; asm volatile("v_cvt_pk_bf16_f32 %0, %1, %2" : "=v"(r) : "v"(lo), "v"(hi)); return r; }
struct EpiBf16 {
    static constexpr bool PERM = true, AFTER_DRAIN = false;
    bf16_t* O; int ldc; const float* bias;
    __device__ __forceinline__ void operator()(const f32x4 (&acc)[2][2][4][2], const Unit& u, int wr, int wc, int fr, int fq) const {
        const int row0 = u.pm * BM + wr * 64 + fr; const int col0 = u.pn * BM + wc * 32 + 8 * fq;
        f32x4 bv[2][2];
#pragma unroll
        for (int bj = 0; bj < 2; ++bj)
#pragma unroll
            for (int n = 0; n < 2; ++n) bv[bj][n] = *(const f32x4*)(bias + col0 + bj * HALF + 4 * n);
#pragma unroll
        for (int ai = 0; ai < 2; ++ai)
#pragma unroll
            for (int m = 0; m < 4; ++m) { bf16_t* rowp = O + (size_t)(row0 + ai * HALF + m * 16) * ldc + col0;
#pragma unroll
                for (int bj = 0; bj < 2; ++bj) { const f32x4 v0 = acc[ai][bj][m][0] + bv[bj][0], v1 = acc[ai][bj][m][1] + bv[bj][1];
                    u32x4 w; w.x = cvt_pk_bf16(v0[0], v0[1]); w.y = cvt_pk_bf16(v0[2], v0[3]); w.z = cvt_pk_bf16(v1[0], v1[1]); w.w = cvt_pk_bf16(v1[2], v1[3]);
                    *(u32x4*)(rowp + bj * HALF) = w; } }
    }
};
struct EpiRes {
    static constexpr bool PERM = false, AFTER_DRAIN = false;
    const float* base; float* out; int ldc; float alpha;
    __device__ __forceinline__ void operator()(const f32x4 (&acc)[2][2][4][2], const Unit& u, int wr, int wc, int fr, int fq) const {
        const int col0 = u.pn * BM + wc * 32 + 4 * fq;
#pragma unroll
        for (int ai = 0; ai < 2; ++ai)
#pragma unroll
            for (int m = 0; m < 4; ++m) { const size_t off = (size_t)(u.pm * BM + ai * HALF + wr * 64 + m * 16 + fr) * ldc + col0;
#pragma unroll
                for (int bj = 0; bj < 2; ++bj)
#pragma unroll
                    for (int n = 0; n < 2; ++n) { const f32x4 bs = *(const f32x4*)(base + off + bj * HALF + n * 16);
                        *(f32x4*)(out + off + bj * HALF + n * 16) = bs * alpha + acc[ai][bj][m][n]; } }
    }
};
struct EpiSwiglu {
    static constexpr bool PERM = true, AFTER_DRAIN = false;
    bf16_t* O; int ldc;
    __device__ __forceinline__ void operator()(const f32x4 (&acc)[2][2][4][2], const Unit& u, int wr, int wc, int fr, int fq) const {
        const int row0 = u.pm * BM + wr * 64 + fr; const int col0 = u.pn * HALF + wc * 32 + 8 * fq;
#pragma unroll
        for (int ai = 0; ai < 2; ++ai)
#pragma unroll
            for (int m = 0; m < 4; ++m) { bf16_t* rowp = O + (size_t)(row0 + ai * HALF + m * 16) * ldc + col0;
                float hv[8];
#pragma unroll
                for (int n = 0; n < 2; ++n)
#pragma unroll
                    for (int i = 0; i < 4; ++i) { const float gt = acc[ai][0][m][n][i], up = acc[ai][1][m][n][i];
                        const float sg = __builtin_amdgcn_rcpf(1.0f + __builtin_amdgcn_exp2f(-1.44269504089f * gt));
                        hv[n * 4 + i] = gt * sg * up; }
                u32x4 w; w.x = cvt_pk_bf16(hv[0], hv[1]); w.y = cvt_pk_bf16(hv[2], hv[3]); w.z = cvt_pk_bf16(hv[4], hv[5]); w.w = cvt_pk_bf16(hv[6], hv[7]);
                *(u32x4*)rowp = w; }
    }
};

template <class Epi, class Sched, bool ALIGN_EPI = false, bool SP2 = false>
__device__ __forceinline__ void gemm_phase(PG8_LAS unsigned char* lds, const Gemm g, const Sched& S, const Epi& E) {
    const int tid = threadIdx.x, wid = __builtin_amdgcn_readfirstlane(tid >> 6), lane = tid & 63, wr = wid >> 2, wc = wid & 3, fr = lane & 15, fq = lane >> 4;
    const int K = g.K, nt = K / BK;
    unsigned voffA[2], voffB[2];
#pragma unroll
    for (int i = 0; i < 2; ++i) { int R, C; stage_rc(tid * 16 + i * 8192, R, C); const int Rb = Epi::PERM ? ((R & ~31) + perm32(R & 31)) : R;
        voffA[i] = (unsigned)(R * K + C) * 2u; voffB[i] = (unsigned)(Rb * K + C) * 2u; }
    const size_t kstep = (size_t)(BK * 2);
    const size_t hstep = (size_t)HALF * K * 2;
    const size_t tstep = 2 * hstep;
    const unsigned ldsw = (unsigned)wid * 1024u;
    const int aoff = lds_byte(wr * 64 + fr, fq * 8), boff = lds_byte(wc * 32 + fr, fq * 8);
#define PG8_SA(b, h) (((b) * 2 + (h)) * HTB)
#define PG8_SB(b, h) ((4 + (b) * 2 + (h)) * HTB)
#define PG8_STAGE(bufoff, gbase, voff) do { _Pragma("unroll") for (int _i = 0; _i < 2; ++_i) \
        __builtin_amdgcn_global_load_lds((const unsigned*)((const char*)(gbase) + (voff)[_i]), (PG8_LAS unsigned*)(lds + (bufoff) + ldsw + _i * 8192), 16, 0, 0); } while (0)
#define PG8_LDA(dst, b, h) do { _Pragma("unroll") for (int m = 0; m < 4; ++m) _Pragma("unroll") for (int k = 0; k < 2; ++k) dst[m][k] = *(const PG8_LAS bf16x8*)(lds + PG8_SA(b, h) + aoff + m * 2048 + k * 1024); } while (0)
#define PG8_LDB(dst, b, h) do { _Pragma("unroll") for (int n = 0; n < 2; ++n) _Pragma("unroll") for (int k = 0; k < 2; ++k) dst[n][k] = *(const PG8_LAS bf16x8*)(lds + PG8_SB(b, h) + boff + n * 2048 + k * 1024); } while (0)
#define PG8_MMA(ai, bj, At, Bt) do { __builtin_amdgcn_s_setprio(1); _Pragma("unroll") for (int m = 0; m < 4; ++m) _Pragma("unroll") for (int n = 0; n < 2; ++n) _Pragma("unroll") for (int k = 0; k < 2; ++k) \
        acc[ai][bj][m][n] = __builtin_amdgcn_mfma_f32_16x16x32_bf16(Bt[n][k], At[m][k], acc[ai][bj][m][n], 0, 0, 0); __builtin_amdgcn_s_setprio(0); } while (0)
#define PG8_WAIT_V(n) asm volatile("s_waitcnt vmcnt(" #n ")" ::: "memory")
#define PG8_WAIT_L(n) asm volatile("s_waitcnt lgkmcnt(" #n ")" ::: "memory")
#define PG8_BAR __builtin_amdgcn_s_barrier()
#define PG8_SCHED __builtin_amdgcn_sched_barrier(0)
    Unit cur, nxt; int ui = 0;
    if (!S.next(0, cur)) return;
    f32x4 acc[2][2][4][2];
#pragma unroll
    for (int a = 0; a < 2; ++a)
#pragma unroll
        for (int b = 0; b < 2; ++b)
#pragma unroll
            for (int m = 0; m < 4; ++m)
#pragma unroll
                for (int n = 0; n < 2; ++n) acc[a][b][m][n] = (f32x4){0.f, 0.f, 0.f, 0.f};
    bf16x8 At[4][2], B0[2][2], B1[2][2];
    const char* cA = (const char*)g.A + (size_t)cur.pm * tstep; const char* cB = (const char*)g.Bt + (size_t)cur.pn * tstep;
    S.a_ready(cur);
    if constexpr (SP2) {
        PG8_STAGE(PG8_SB(0, 0), cB, voffB); PG8_STAGE(PG8_SB(0, 1), cB + hstep, voffB); PG8_STAGE(PG8_SA(0, 0), cA, voffA); PG8_STAGE(PG8_SA(0, 1), cA + hstep, voffA);
        if (wr == 1) PG8_BAR;
        PG8_WAIT_V(2); PG8_BAR;
        PG8_STAGE(PG8_SB(1, 0), cB + kstep, voffB); PG8_STAGE(PG8_SA(1, 0), cA + kstep, voffA); PG8_STAGE(PG8_SB(1, 1), cB + hstep + kstep, voffB);
        PG8_WAIT_V(6); PG8_BAR;
    } else {
        PG8_STAGE(PG8_SB(0, 0), cB, voffB); PG8_STAGE(PG8_SA(0, 0), cA, voffA); PG8_STAGE(PG8_SB(0, 1), cB + hstep, voffB); PG8_STAGE(PG8_SA(0, 1), cA + hstep, voffA);
        if (wr == 1) PG8_BAR;
        PG8_WAIT_V(4); PG8_BAR;
        PG8_STAGE(PG8_SB(1, 0), cB + kstep, voffB); PG8_STAGE(PG8_SA(1, 0), cA + kstep, voffA); PG8_STAGE(PG8_SB(1, 1), cB + hstep + kstep, voffB);
        PG8_WAIT_V(6); PG8_BAR;
    }
    for (;;) {
        const bool has_next = S.next(ui + 1, nxt);
        const char* nA = has_next ? (const char*)g.A + (size_t)nxt.pm * tstep : cA; const char* nB = has_next ? (const char*)g.Bt + (size_t)nxt.pn * tstep : cB;
        for (int t = 0; t < nt; t += 2) {
            const bool last = (t == nt - 2);
            const char* a1 = cA + (size_t)(t + 1) * kstep;
            const char* a2 = last ? nA : cA + (size_t)(t + 2) * kstep; const char* b2 = last ? nB : cB + (size_t)(t + 2) * kstep;
            const char* a3 = a2 + kstep; const char* b3 = b2 + kstep;
            if (last && has_next) S.a_ready(nxt);
            if constexpr (SP2) {
            PG8_LDB(B0, 0, 0); PG8_LDB(B1, 0, 1); PG8_SCHED; PG8_LDA(At, 0, 0); PG8_STAGE(PG8_SA(1, 1), a1 + hstep, voffA);
            PG8_WAIT_V(8); PG8_WAIT_L(0); PG8_BAR; PG8_MMA(0, 0, At, B0); PG8_MMA(0, 1, At, B1); PG8_BAR; PG8_SCHED;
            PG8_LDA(At, 0, 1); PG8_STAGE(PG8_SB(0, 0), b2, voffB); PG8_STAGE(PG8_SB(0, 1), b2 + hstep, voffB); PG8_STAGE(PG8_SA(0, 0), a2, voffA);
            PG8_WAIT_V(8); PG8_WAIT_L(0); PG8_BAR; PG8_MMA(1, 0, At, B0); PG8_MMA(1, 1, At, B1); PG8_BAR; PG8_SCHED;
            PG8_LDB(B0, 1, 0); PG8_LDB(B1, 1, 1); PG8_SCHED; PG8_LDA(At, 1, 0); PG8_STAGE(PG8_SA(0, 1), a2 + hstep, voffA);
            PG8_WAIT_V(8); PG8_WAIT_L(0); PG8_BAR; PG8_MMA(0, 0, At, B0); PG8_MMA(0, 1, At, B1); PG8_BAR; PG8_SCHED;
            PG8_LDA(At, 1, 1); PG8_STAGE(PG8_SB(1, 0), b3, voffB); PG8_STAGE(PG8_SB(1, 1), b3 + hstep, voffB); PG8_STAGE(PG8_SA(1, 0), a3, voffA);
            PG8_WAIT_V(8); PG8_WAIT_L(0); PG8_BAR; PG8_MMA(1, 0, At, B0); PG8_MMA(1, 1, At, B1); PG8_BAR; PG8_SCHED;
            } else {
            PG8_LDB(B0, 0, 0); PG8_SCHED; PG8_LDA(At, 0, 0); PG8_STAGE(PG8_SA(1, 1), a1 + hstep, voffA);
            PG8_WAIT_L(8); PG8_BAR; PG8_WAIT_L(0); PG8_MMA(0, 0, At, B0); PG8_BAR; PG8_SCHED;
            PG8_LDB(B1, 0, 1); PG8_STAGE(PG8_SB(0, 0), b2, voffB);
            PG8_BAR; PG8_WAIT_L(0); PG8_MMA(0, 1, At, B1); PG8_BAR;
            PG8_LDA(At, 0, 1); PG8_STAGE(PG8_SA(0, 0), a2, voffA);
            PG8_BAR; PG8_WAIT_L(0); PG8_MMA(1, 0, At, B0); PG8_BAR; PG8_SCHED;
            PG8_STAGE(PG8_SB(0, 1), b2 + hstep, voffB);
            PG8_WAIT_V(6); PG8_BAR; PG8_MMA(1, 1, At, B1); PG8_BAR;
            PG8_LDB(B0, 1, 0); PG8_SCHED; PG8_LDA(At, 1, 0); PG8_STAGE(PG8_SA(0, 1), a2 + hstep, voffA);
            PG8_WAIT_L(8); PG8_BAR; PG8_WAIT_L(0); PG8_MMA(0, 0, At, B0); PG8_BAR; PG8_SCHED;
            PG8_LDB(B1, 1, 1); PG8_STAGE(PG8_SB(1, 0), b3, voffB);
            PG8_BAR; PG8_WAIT_L(0); PG8_MMA(0, 1, At, B1); PG8_BAR;
            PG8_LDA(At, 1, 1); PG8_STAGE(PG8_SA(1, 0), a3, voffA);
            PG8_BAR; PG8_WAIT_L(0); PG8_MMA(1, 0, At, B0); PG8_BAR; PG8_SCHED;
            PG8_STAGE(PG8_SB(1, 1), b3 + hstep, voffB);
            PG8_WAIT_V(6); PG8_BAR; PG8_MMA(1, 1, At, B1); PG8_BAR;
            }
        }
        if constexpr (ALIGN_EPI) { if (wr == 0) PG8_BAR; }
        if constexpr (!Epi::AFTER_DRAIN) { E(acc, cur, wr, wc, fr, fq); S.done(cur); }
        if (!has_next) break;
#pragma unroll
        for (int a = 0; a < 2; ++a)
#pragma unroll
            for (int b = 0; b < 2; ++b)
#pragma unroll
                for (int m = 0; m < 4; ++m)
#pragma unroll
                    for (int n = 0; n < 2; ++n) acc[a][b][m][n] = (f32x4){0.f, 0.f, 0.f, 0.f};
        cur = nxt; cA = nA; cB = nB; ++ui;
        if constexpr (ALIGN_EPI) { if (wr == 1) PG8_BAR; }
    }
    PG8_WAIT_V(0);
    if constexpr (!ALIGN_EPI) { if (wr == 0) PG8_BAR; }
    PG8_BAR;
    if constexpr (Epi::AFTER_DRAIN) { E.fused(acc, cur, wr, wc, fr, fq, lds, wid, lane); S.done(cur); }
#undef PG8_SA
#undef PG8_SB
#undef PG8_STAGE
#undef PG8_LDA
#undef PG8_LDB
#undef PG8_MMA
#undef PG8_WAIT_V
#undef PG8_WAIT_L
#undef PG8_BAR
#undef PG8_SCHED
}
}

namespace cg = cooperative_groups;
#define GAS __attribute__((address_space(1)))
#define LAS __attribute__((address_space(3)))
typedef unsigned short bf16;
typedef unsigned v4u __attribute__((ext_vector_type(4)));
typedef unsigned v2u __attribute__((ext_vector_type(2)));
typedef float f32x4 __attribute__((ext_vector_type(4)));
typedef short bf16x8 __attribute__((ext_vector_type(8)));
typedef short s16x4 __attribute__((ext_vector_type(4)));

constexpr int NWAVES = 8, NTHREADS = NWAVES * 64;
constexpr int S = 16384, DM = 2048, INW = 4352, DFF = 5632, NUP = 2 * DFF;
constexpr int QA_OFF = 0, KA_OFF = 1024, VA_OFF = 2048, QB_OFF = 3072, KB_OFF = 4096, VB_OFF = 4224;
constexpr float ALPHA = 1.189207115002721f;
constexpr float LN_EPS = 1e-5f, RMS_EPS = 1e-6f;
constexpr int LDS_BYTES = 147456;

constexpr size_t MiB = 1u << 20;
constexpr size_t WS_SSQ = 0;
constexpr size_t WS_COSA = 1 * MiB, WS_SINA = 5 * MiB, WS_COSB = 9 * MiB, WS_SINB = 11 * MiB;
constexpr size_t WS_WI = 16 * MiB, WS_WO = 33 * MiB, WS_WU = 41 * MiB, WS_WD = 85 * MiB;
constexpr size_t WS_XB = 108 * MiB;
constexpr size_t WS_PROJ = 172 * MiB;
constexpr size_t WS_Y = 308 * MiB;
constexpr size_t WS_H = 172 * MiB;
constexpr size_t WS_END = 372 * MiB;
static_assert(WS_WI + (size_t)INW * DM * 2 <= WS_WO && WS_WO + (size_t)DM * DM * 2 <= WS_WU && WS_WU + (size_t)NUP * DM * 2 <= WS_WD && WS_WD + (size_t)DM * DFF * 2 <= WS_XB, "ws map (weights)");
static_assert(WS_XB + (size_t)S * DM * 2 <= WS_PROJ && WS_PROJ + (size_t)S * INW * 2 <= WS_Y && WS_Y + (size_t)S * DM * 2 <= WS_END && WS_H + (size_t)S * DFF * 2 <= WS_END, "ws map (activations)");

__device__ __forceinline__ unsigned f2bf(float f) { unsigned u = __builtin_bit_cast(unsigned, f); return (u + 0x7fffu + ((u >> 16) & 1u)) >> 16; }
__device__ __forceinline__ unsigned pk2(float lo, float hi) { return f2bf(lo) | (f2bf(hi) << 16); }
__device__ __forceinline__ float bflo(unsigned w) { return __builtin_bit_cast(float, w << 16); }
__device__ __forceinline__ float bfhi(unsigned w) { return __builtin_bit_cast(float, w & 0xffff0000u); }
#define LDS_WAIT() asm volatile("s_waitcnt lgkmcnt(0)" ::: "memory")

__device__ __forceinline__ float wave_sum(float v) {
#pragma unroll
    for (int o = 1; o < 64; o <<= 1) v += __shfl_xor(v, o);
    return v;
}

__device__ __forceinline__ void p0_transpose_item(const float* W, int K, int N, bf16* WT, int k0, int n0, int drow0, LAS float* scr, int lane) {
#pragma unroll 8
    for (int i = 0; i < 32; ++i) { const int kk = 2 * i + (lane >> 5); scr[kk * 33 + (lane & 31)] = W[(size_t)(k0 + kk) * N + n0 + (lane & 31)]; }
    LDS_WAIT(); asm volatile("" ::: "memory");
    const int c = lane & 7;
#pragma unroll
    for (int j = 0; j < 4; ++j) { const int n = (lane >> 3) + 8 * j; const LAS float* s = scr + (8 * c) * 33 + n;
        v4u o; o.x = pk2(s[0 * 33], s[1 * 33]); o.y = pk2(s[2 * 33], s[3 * 33]); o.z = pk2(s[4 * 33], s[5 * 33]); o.w = pk2(s[6 * 33], s[7 * 33]);
        *(v4u*)(WT + (size_t)(drow0 + n) * K + k0 + 8 * c) = o; }
    LDS_WAIT(); asm volatile("" ::: "memory");
}

struct Args { const float* in[13]; float* out; unsigned char* ws; };

__device__ __forceinline__ void phase_prologue(const Args& a, LAS unsigned char* lds, int gw, int NGW, int lane, int wave) {
    unsigned char* ws = a.ws;
    LAS float* scr = (LAS float*)(lds + wave * 16384);
    const float* w_in = a.in[1]; const float* w_out = a.in[6]; const float* w_up = a.in[9]; const float* w_down = a.in[10];
    bf16* Wi = (bf16*)(ws + WS_WI); bf16* Wo = (bf16*)(ws + WS_WO); bf16* Wu = (bf16*)(ws + WS_WU); bf16* Wd = (bf16*)(ws + WS_WD);
    constexpr int I_IN = (DM / 64) * (INW / 32), I_OUT = (DM / 64) * (DM / 32), I_UP = (DM / 64) * (NUP / 32), I_DN = (DFF / 64) * (DM / 32);
    constexpr int NITEMS = I_IN + I_OUT + I_UP + I_DN;
    for (int it = gw; it < NITEMS; it += NGW) {
        int r = it;
        if (r < I_IN) { const int nb = INW / 32, kb = r / nb, n0 = (r % nb) * 32; p0_transpose_item(w_in, DM, INW, Wi, kb * 64, n0, n0, scr, lane); continue; } r -= I_IN;
        if (r < I_OUT) { const int nb = DM / 32, kb = r / nb, n0 = (r % nb) * 32; p0_transpose_item(w_out, DM, DM, Wo, kb * 64, n0, n0, scr, lane); continue; } r -= I_OUT;
        if (r < I_UP) { const int nb = NUP / 32, kb = r / nb, n0 = (r % nb) * 32; const int half = n0 / DFF, rem = n0 % DFF;
            p0_transpose_item(w_up, DM, NUP, Wu, kb * 64, n0, 256 * (rem / 128) + 128 * half + (rem % 128), scr, lane); continue; } r -= I_UP;
        { const int nb = DM / 32, kb = r / nb, n0 = (r % nb) * 32; p0_transpose_item(w_down, DFF, DM, Wd, kb * 64, n0, n0, scr, lane); }
    }
    const int gt = gw * 64 + lane, NGT = NGW * 64;
    { const f32x4* x4 = (const f32x4*)a.in[0]; v4u* xb = (v4u*)(ws + WS_XB);
      for (int i = gt; i < S * DM / 8; i += NGT) { const f32x4 p = x4[2 * i], q = x4[2 * i + 1]; v4u o; o.x = pk2(p[0], p[1]); o.y = pk2(p[2], p[3]); o.z = pk2(q[0], q[1]); o.w = pk2(q[2], q[3]); xb[i] = o; } }
    { float* cA = (float*)(ws + WS_COSA); float* sA = (float*)(ws + WS_SINA); float* cB = (float*)(ws + WS_COSB); float* sB = (float*)(ws + WS_SINB);
      for (int i = gt; i < S * 96; i += NGT) { const int pos = i / 96, j = i % 96; const bool isA = j < 64; const int jj = isA ? j : j - 64;
          const double e = -(double)jj * (isA ? (13.287712379549449 / 64.0) : (13.287712379549449 / 32.0));
          const double inv = exp2(e); double turns = (double)pos * inv * 0.15915494309189535; turns -= floor(turns);
          const float fr = (float)turns; const float cv = __builtin_amdgcn_cosf(fr), sv = __builtin_amdgcn_sinf(fr);
          if (isA) { cA[pos * 64 + jj] = cv; sA[pos * 64 + jj] = sv; } else { cB[pos * 32 + jj] = cv; sB[pos * 32 + jj] = sv; } } }
    { float* ssq = (float*)(ws + WS_SSQ); for (int i = gt; i < S * 2; i += NGT) ssq[i] = 0.f; }
}

__device__ __forceinline__ void phase_rope(const Args& a, int gt, int NGT) {
    unsigned char* ws = a.ws; bf16* proj = (bf16*)(ws + WS_PROJ);
    const float* cA = (const float*)(ws + WS_COSA); const float* sA = (const float*)(ws + WS_SINA); const float* cB = (const float*)(ws + WS_COSB); const float* sB = (const float*)(ws + WS_SINB);
    for (int it = gt; it < S * 200; it += NGT) {
        const int pos = it / 200, i = it % 200; int col, pcol; const float *ct, *st;
        if (i < 128) { col = (i >> 3) * 128 + (i & 7) * 8; pcol = col + 64; ct = cA + pos * 64 + (i & 7) * 8; st = sA + pos * 64 + (i & 7) * 8; }
        else { const int j = i - 128; col = QB_OFF + (j >> 2) * 64 + (j & 3) * 8; pcol = col + 32; ct = cB + pos * 32 + (j & 3) * 8; st = sB + pos * 32 + (j & 3) * 8; }
        v4u* p1 = (v4u*)(proj + (size_t)pos * INW + col); v4u* p2 = (v4u*)(proj + (size_t)pos * INW + pcol);
        const v4u u1 = *p1, u2 = *p2; const f32x4 c0 = *(const f32x4*)ct, c1 = *(const f32x4*)(ct + 4), s0 = *(const f32x4*)st, s1 = *(const f32x4*)(st + 4);
        v4u o1, o2;
#pragma unroll
        for (int e = 0; e < 4; ++e) { const float xa = bflo(u1[e]), xb = bfhi(u1[e]), ya = bflo(u2[e]), yb = bfhi(u2[e]);
            const float ca = e < 2 ? c0[2 * e] : c1[2 * e - 4], cb = e < 2 ? c0[2 * e + 1] : c1[2 * e - 3], sa = e < 2 ? s0[2 * e] : s1[2 * e - 4], sb = e < 2 ? s0[2 * e + 1] : s1[2 * e - 3];
            o1[e] = pk2(xa * ca - ya * sa, xb * cb - yb * sb); o2[e] = pk2(ya * ca + xa * sa, yb * cb + xb * sb); }
        *p1 = o1; *p2 = o2;
    }
}

namespace att {
constexpr int VROW = 288, KROW = 272, VBUF = 32 * VROW, KBUF = 32 * KROW, WBUF = VBUF + KBUF;
__device__ __forceinline__ s16x4 vtr(const LAS unsigned char* p) { typedef short v4i16_t __attribute__((ext_vector_type(4)));
    return __builtin_bit_cast(s16x4, __builtin_amdgcn_ds_read_tr16_b64_v4i16((LAS v4i16_t*)p)); }
__device__ __forceinline__ unsigned cvtpk(float lo, float hi) { unsigned r; asm volatile("v_cvt_pk_bf16_f32 %0, %1, %2" : "=v"(r) : "v"(lo), "v"(hi)); return r; }

template <int D> struct KVS { bf16x8 k[D / 16]; bf16x8 v[D / 16]; };

template <int D>
__device__ __forceinline__ void load_kv(KVS<D>& t, const bf16* kcol, const bf16* vcol, int kbase, int dil, int b, int lane) {
    constexpr int CPR = D / 8;
#pragma unroll
    for (int i = 0; i < D / 16; ++i) { const int n = lane + 64 * i, row = n / CPR, ch = n % CPR; int kp = kbase + dil * (32 * b + row); kp = kp < 0 ? 0 : (kp > S - 1 ? S - 1 : kp);
        const size_t ro = (size_t)kp * INW + 8 * ch; t.k[i] = *(const bf16x8*)(kcol + ro); t.v[i] = *(const bf16x8*)(vcol + ro); }
}

template <int D>
__device__ __forceinline__ void span(f32x4 (&o)[D / 16], float& m, float& l, const bf16x8 (&qf)[D / 32], const bf16* kcol, const bf16* vcol,
                                     int kbase, int dil, int nblk, int tqrel, int maxdist, float sc, LAS unsigned char* kl, LAS unsigned char* vl, int lane) {
    const int c = lane & 15, g = lane >> 4, q4 = (lane & 15) >> 2, p4 = lane & 3;
    constexpr int CPR = D / 8;
    KVS<D> st;
    load_kv<D>(st, kcol, vcol, kbase, dil, 0, lane);
    for (int b = 0; b < nblk; ++b) {
#pragma unroll
        for (int i = 0; i < D / 16; ++i) { const int n = lane + 64 * i, row = n / CPR, ch = n % CPR; *(LAS bf16x8*)(kl + row * KROW + ch * 16) = st.k[i]; *(LAS bf16x8*)(vl + row * VROW + ch * 16) = st.v[i]; }
        if (b + 1 < nblk) load_kv<D>(st, kcol, vcol, kbase, dil, b + 1, lane);
        f32x4 a0 = {0.f, 0.f, 0.f, 0.f}, a1 = {0.f, 0.f, 0.f, 0.f};
#pragma unroll
        for (int ks = 0; ks < D / 32; ++ks) { const bf16x8 k0 = *(const LAS bf16x8*)(kl + c * KROW + 64 * ks + 16 * g), k1 = *(const LAS bf16x8*)(kl + (16 + c) * KROW + 64 * ks + 16 * g);
            a0 = __builtin_amdgcn_mfma_f32_16x16x32_bf16(k0, qf[ks], a0, 0, 0, 0); a1 = __builtin_amdgcn_mfma_f32_16x16x32_bf16(k1, qf[ks], a1, 0, 0, 0); }
        float s[8];
#pragma unroll
        for (int e = 0; e < 8; ++e) { const int jj = 32 * b + 16 * (e >> 2) + 4 * g + (e & 3); const int dist = tqrel - dil * jj; const bool ok = ((unsigned)dist <= (unsigned)maxdist) && (kbase + dil * jj >= 0);
            const float v = (e < 4 ? a0[e & 3] : a1[e & 3]) * sc; s[e] = ok ? v : -INFINITY; }
        float ml = fmaxf(fmaxf(fmaxf(s[0], s[1]), fmaxf(s[2], s[3])), fmaxf(fmaxf(s[4], s[5]), fmaxf(s[6], s[7])));
        ml = fmaxf(ml, __shfl_xor(ml, 16)); ml = fmaxf(ml, __shfl_xor(ml, 32));
        const float mn = fmaxf(m, ml); const float ms = (mn == -INFINITY) ? 0.f : mn;
        const float alpha = __builtin_amdgcn_exp2f(m - ms);
        float p[8], ps = 0.f;
#pragma unroll
        for (int e = 0; e < 8; ++e) { p[e] = __builtin_amdgcn_exp2f(s[e] - ms); ps += p[e]; }
        l = l * alpha + ps; m = mn;
#pragma unroll
        for (int nt = 0; nt < D / 16; ++nt) o[nt] = o[nt] * alpha;
        v4u pw; pw.x = cvtpk(p[0], p[1]); pw.y = cvtpk(p[2], p[3]); pw.z = cvtpk(p[4], p[5]); pw.w = cvtpk(p[6], p[7]);
        const bf16x8 pf = __builtin_bit_cast(bf16x8, pw);
#pragma unroll
        for (int nt = 0; nt < D / 16; ++nt) {
            const s16x4 r1 = vtr(vl + (4 * g + q4) * VROW + (16 * nt + 4 * p4) * 2), r2 = vtr(vl + (16 + 4 * g + q4) * VROW + (16 * nt + 4 * p4) * 2);
            bf16x8 vf; vf[0] = r1[0]; vf[1] = r1[1]; vf[2] = r1[2]; vf[3] = r1[3]; vf[4] = r2[0]; vf[5] = r2[1]; vf[6] = r2[2]; vf[7] = r2[3];
            o[nt] = __builtin_amdgcn_mfma_f32_16x16x32_bf16(vf, pf, o[nt], 0, 0, 0);
        }
    }
}

template <int D>
__device__ __forceinline__ void finish(const f32x4 (&o)[D / 16], float ltot, bf16* yrow  , float* ssqp, int lane) {
    const float inv = 1.0f / ltot; float sq = 0.f;
#pragma unroll
    for (int nt = 0; nt < D / 16; ++nt) { const f32x4 v = o[nt] * inv; sq += (v[0] * v[0] + v[1] * v[1]) + (v[2] * v[2] + v[3] * v[3]);
        v2u w; w.x = cvtpk(v[0], v[1]); w.y = cvtpk(v[2], v[3]); *(v2u*)(yrow + 16 * nt) = w; }
    sq += __shfl_xor(sq, 16); sq += __shfl_xor(sq, 32);
    if ((lane >> 4) == 0) atomicAdd(ssqp, sq);
}
}

__device__ __forceinline__ void phase_attention(const Args& a, LAS unsigned char* lds, int gw, int NGW, int lane, int wave) {
    unsigned char* ws = a.ws; const bf16* proj = (const bf16*)(ws + WS_PROJ); bf16* Y = (bf16*)(ws + WS_Y); float* ssq = (float*)(ws + WS_SSQ);
    const float* sinks = a.in[3];
    LAS unsigned char* vl = lds + wave * att::WBUF; LAS unsigned char* kl = vl + att::VBUF;
    const int c = lane & 15, g = lane >> 4;
    const int G_ = NGW / NWAVES; const bool xa = (G_ % 8) == 0; const int wpx = xa ? (G_ / 8) * NWAVES : NGW;
    const int ti0 = xa ? ((int)(blockIdx.x >> 3) * NWAVES + wave) : gw; const int nti = xa ? 1024 : 8 * 1024;
    for (int ti = ti0; ti < nti; ti += wpx) {
        const int t = xa ? (((int)blockIdx.x & 7) << 10) + ti : ti;
        const int r = t & 15, mb = (t >> 4) & 63, h = t >> 10; const int t0 = r + 256 * mb, tq = t0 + 16 * c;
        bf16x8 qf[4];
#pragma unroll
        for (int ks = 0; ks < 4; ++ks) qf[ks] = *(const bf16x8*)(proj + (size_t)tq * INW + QA_OFF + h * 128 + 32 * ks + 8 * g);
        f32x4 o[8];
#pragma unroll
        for (int nt = 0; nt < 8; ++nt) o[nt] = (f32x4){0.f, 0.f, 0.f, 0.f};
        float m = -INFINITY, l = 0.f;
        const bf16* kcol = proj + KA_OFF + h * 128; const bf16* vcol = proj + VA_OFF + h * 128;
        const float sc = 1.44269504089f * 0.08838834764831845f;
        att::span<128>(o, m, l, qf, kcol, vcol, t0 - 128, 1, 12, 16 * c + 128, 128, sc, kl, vl, lane);
        att::span<128>(o, m, l, qf, kcol, vcol, t0 - 512, 4, 6, 16 * c + 512, 512, sc, kl, vl, lane);
        att::span<128>(o, m, l, qf, kcol, vcol, t0 - 2048, 16, 5, 16 * c + 2048, 2048, sc, kl, vl, lane);
        float lt = l; lt += __shfl_xor(lt, 16); lt += __shfl_xor(lt, 32);
        att::finish<128>(o, lt, Y + (size_t)tq * DM + h * 128 + 4 * g, ssq + 2 * tq, lane);
    }
    for (int t = gw; t < 16 * 1024; t += NGW) {
        const int hl = t & 7, pb = (t >> 3) & 1023, kvh = t >> 13, hq = kvh * 8 + hl; const int tq = 16 * pb + c;
        bf16x8 qf[2];
#pragma unroll
        for (int ks = 0; ks < 2; ++ks) qf[ks] = *(const bf16x8*)(proj + (size_t)tq * INW + QB_OFF + hq * 64 + 32 * ks + 8 * g);
        f32x4 o[4];
#pragma unroll
        for (int nt = 0; nt < 4; ++nt) o[nt] = (f32x4){0.f, 0.f, 0.f, 0.f};
        float m = -INFINITY, l = 0.f;
        const bf16* kcol = proj + KB_OFF + kvh * 64; const bf16* vcol = proj + VB_OFF + kvh * 64;
        att::span<64>(o, m, l, qf, kcol, vcol, 16 * pb - 128, 1, 5, c + 128, 127, 1.44269504089f * 0.125f, kl, vl, lane);
        float lt = l; lt += __shfl_xor(lt, 16); lt += __shfl_xor(lt, 32);
        lt += __builtin_amdgcn_exp2f(sinks[hq] * 1.44269504089f - m);
        att::finish<64>(o, lt, Y + (size_t)tq * DM + 1024 + hq * 64 + 4 * g, ssq + 2 * tq + 1, lane);
    }
}

__device__ __forceinline__ void phase_rms(const Args& a, int gt, int NGT) {
    unsigned char* ws = a.ws; v4u* Y = (v4u*)(ws + WS_Y); const float* ssq = (const float*)(ws + WS_SSQ);
    const float* ga = a.in[4]; const float* gb = a.in[5];
    for (int i = gt; i < S * DM / 8; i += NGT) { const int pos = i >> 8, c8 = (i & 255) * 8; const int grp = c8 >> 10;
        const float rs = 1.0f / sqrtf(ssq[2 * pos + grp] * (1.0f / 1024.0f) + RMS_EPS);
        const float* gp = grp ? gb + (c8 - 1024) : ga + c8; const f32x4 g0 = *(const f32x4*)gp, g1 = *(const f32x4*)(gp + 4);
        const v4u u = Y[i]; v4u o;
        o.x = pk2(bflo(u.x) * rs * g0[0], bfhi(u.x) * rs * g0[1]); o.y = pk2(bflo(u.y) * rs * g0[2], bfhi(u.y) * rs * g0[3]);
        o.z = pk2(bflo(u.z) * rs * g1[0], bfhi(u.z) * rs * g1[1]); o.w = pk2(bflo(u.w) * rs * g1[2], bfhi(u.w) * rs * g1[3]);
        Y[i] = o; }
}

__device__ __forceinline__ void phase_ln(float* buf, const float* gam, const float* bet, bf16* xb, int gw, int NGW, int lane) {
    for (int row = gw; row < S; row += NGW) {
        f32x4* xr = (f32x4*)(buf + (size_t)row * DM) + lane;
        f32x4 v[8]; float s = 0.f;
#pragma unroll
        for (int j = 0; j < 8; ++j) { v[j] = xr[64 * j]; s += (v[j][0] + v[j][1]) + (v[j][2] + v[j][3]); }
        const float mean = wave_sum(s) * (1.f / DM); float s2 = 0.f;
#pragma unroll
        for (int j = 0; j < 8; ++j) { v[j] = v[j] - mean; s2 += (v[j][0] * v[j][0] + v[j][1] * v[j][1]) + (v[j][2] * v[j][2] + v[j][3] * v[j][3]); }
        const float rstd = 1.f / sqrtf(wave_sum(s2) * (1.f / DM) + LN_EPS);
#pragma unroll
        for (int j = 0; j < 8; ++j) { const f32x4 gg = *((const f32x4*)gam + lane + 64 * j), bb = *((const f32x4*)bet + lane + 64 * j);
            const f32x4 ov = v[j] * rstd * gg + bb; xr[64 * j] = ov;
            if (xb) { v2u w; w.x = pk2(ov[0], ov[1]); w.y = pk2(ov[2], ov[3]); *((v2u*)(xb + (size_t)row * DM) + lane + 64 * j) = w; } }
    }
}

__global__ void __launch_bounds__(NTHREADS, 2) hymba_fwd(Args args) {
    extern __shared__ __attribute__((aligned(16))) unsigned char lds_raw[];
    LAS unsigned char* lds = (LAS unsigned char*)lds_raw;
    cg::grid_group grid = cg::this_grid();
    const int tid = threadIdx.x, lane = tid & 63, wave = __builtin_amdgcn_readfirstlane(tid >> 6);
    const int G = gridDim.x, gw = blockIdx.x * NWAVES + wave, NGW = G * NWAVES, gt = blockIdx.x * NTHREADS + tid, NGT = G * NTHREADS;
    unsigned char* ws = args.ws;
    bf16* Wi = (bf16*)(ws + WS_WI); bf16* Wo = (bf16*)(ws + WS_WO); bf16* Wu = (bf16*)(ws + WS_WU); bf16* Wd = (bf16*)(ws + WS_WD);
    bf16* XB = (bf16*)(ws + WS_XB); bf16* PROJ = (bf16*)(ws + WS_PROJ); bf16* Y = (bf16*)(ws + WS_Y); bf16* H = (bf16*)(ws + WS_H);

    phase_prologue(args, lds, gw, NGW, lane, wave);
    grid.sync();
    {
        pg8::Gemm g{XB, Wi, S, INW, DM}; pg8::StaticOrder So; So.init(S, INW, G, (int)blockIdx.x);
        pg8::EpiBf16 E{PROJ, INW, args.in[2]};
        pg8::gemm_phase<pg8::EpiBf16, pg8::StaticOrder, true, true>(lds, g, So, E);
    }
    grid.sync();
    phase_rope(args, gt, NGT);
    grid.sync();
    phase_attention(args, lds, gw, NGW, lane, wave);
    grid.sync();
    phase_rms(args, gt, NGT);
    grid.sync();
    {
        pg8::Gemm g{Y, Wo, S, DM, DM}; pg8::StaticOrder So; So.init(S, DM, G, (int)blockIdx.x);
        pg8::EpiRes E{args.in[0], args.out, DM, ALPHA};
        pg8::gemm_phase<pg8::EpiRes, pg8::StaticOrder, true, true>(lds, g, So, E);
    }
    grid.sync();
    phase_ln(args.out, args.in[7], args.in[8], XB, gw, NGW, lane);
    grid.sync();
    {
        pg8::Gemm g{XB, Wu, S, NUP, DM}; pg8::StaticOrder So; So.init(S, NUP, G, (int)blockIdx.x);
        pg8::EpiSwiglu E{H, DFF};
        pg8::gemm_phase<pg8::EpiSwiglu, pg8::StaticOrder, true, true>(lds, g, So, E);
    }
    grid.sync();
    {
        pg8::Gemm g{H, Wd, S, DM, DFF}; pg8::StaticOrder So; So.init(S, DM, G, (int)blockIdx.x);
        pg8::EpiRes E{args.out, args.out, DM, ALPHA};
        pg8::gemm_phase<pg8::EpiRes, pg8::StaticOrder, true, true>(lds, g, So, E);
    }
    grid.sync();
    phase_ln(args.out, args.in[11], args.in[12], nullptr, gw, NGW, lane);
}

extern "C" void kernel_launch(void* const* d_in, const int* in_sizes, int n_in, void* d_out, int out_size, void* d_ws, size_t ws_size, hipStream_t stream) {
    static int grid = 0;
    if (grid == 0) {
        if (n_in != 13 || in_sizes[0] != S * DM || out_size != S * DM || ws_size < WS_END) { fprintf(stderr, "kernel_launch: unexpected shapes (n_in %d, in0 %d, out %d, ws %zu)\n", n_in, n_in > 0 ? in_sizes[0] : -1, out_size, ws_size); grid = -1; return; }
        int dev = 0, cus = 0, per_cu = 0;
        if (hipGetDevice(&dev) != hipSuccess || hipDeviceGetAttribute(&cus, hipDeviceAttributeMultiprocessorCount, dev) != hipSuccess) { grid = -1; return; }
        if (hipFuncSetAttribute((const void*)hymba_fwd, hipFuncAttributeMaxDynamicSharedMemorySize, LDS_BYTES) != hipSuccess) { fprintf(stderr, "kernel_launch: hipFuncSetAttribute failed\n"); grid = -1; return; }
        if (hipOccupancyMaxActiveBlocksPerMultiprocessor(&per_cu, (const void*)hymba_fwd, NTHREADS, LDS_BYTES) != hipSuccess || per_cu < 1) { fprintf(stderr, "kernel_launch: occupancy query gave %d\n", per_cu); per_cu = 1; }
        (void)hipGetLastError();
        grid = cus * per_cu;
    }
    if (grid < 0) return;
    Args a{};
    for (int i = 0; i < 13; ++i) a.in[i] = (const float*)d_in[i];
    a.out = (float*)d_out; a.ws = (unsigned char*)d_ws;
    void* kargs[] = {&a};
    hipError_t e = hipLaunchCooperativeKernel((const void*)hymba_fwd, dim3(grid), dim3(NTHREADS), kargs, LDS_BYTES, stream);
    if (e != hipSuccess) fprintf(stderr, "cooperative launch failed: %s (grid %d)\n", hipGetErrorString(e), grid);
}
```

```cpp
#include <hip/hip_runtime.h>
#include <hip/hip_cooperative_groups.h>
#include <cstdio>
#include <cstdint>
#include <cmath>
namespace pg8 {
#define PG8_LAS __attribute__((address_space(3)))
typedef unsigned short bf16_t;
typedef short bf16x8 __attribute__((ext_vector_type(8)));
typedef float f32x4 __attribute__((ext_vector_type(4)));
typedef unsigned u32x4 __attribute__((ext_vector_type(4)));
constexpr int BM = 256, BK = 64, HALF = 128, HTB = HALF * BK * 2  , STAGE_BYTES = 8 * HTB, NXCD = 8, WGM = 8;

__host__ __device__ __forceinline__ int lds_byte(int r, int c) { const int st = (r >> 4) * 2 + (c >> 5), rr = r & 15, cc = c & 31, ob = rr * 64 + cc * 2; return st * 1024 + (ob ^ (((ob >> 9) & 1) << 5)); }
__host__ __device__ __forceinline__ void stage_rc(int b, int& R, int& C) { const int st = b / 1024, sb = b % 1024, swz = sb ^ (((sb >> 9) & 1) << 5); R = (st >> 1) * 16 + swz / 64; C = (st & 1) * 32 + (swz % 64) / 2; }
__host__ __device__ __forceinline__ int perm32(int rho) { const int n = rho >> 4, i = rho & 15; return 8 * (i >> 2) + 4 * n + (i & 3); }

struct Unit { int pm, pn; };
struct Gemm { const bf16_t* A; const bf16_t* Bt; int M, N, K; };

struct StaticOrder {
    int nM, nN, nwg, G, c;
    __host__ __device__ void init(int M, int N, int G_, int c_) { nM = M / BM; nN = N / BM; nwg = nM * nN; G = G_; c = c_; }
    __host__ __device__ bool next(int i, Unit& u) const {
        const long L = (long)i * G + c; if (L >= nwg) return false;
        int wgid = (int)L; { const int q = nwg / NXCD, r = nwg % NXCD, xcd = wgid % NXCD, off = wgid / NXCD; wgid = (xcd < r ? xcd * (q + 1) : r * (q + 1) + (xcd - r) * q) + off; }
        const int nig = WGM * nN, gid = wgid / nig, fm = gid * WGM, gsz = (nM - fm) < WGM ? (nM - fm) : WGM;
        u.pm = fm + ((wgid % nig) % gsz); u.pn = (wgid % nig) / gsz; return true;
    }
    __device__ __forceinline__ void a_ready(const Unit&) const {}
    __device__ __forceinline__ void done(const Unit&) const {}
};

__device__ __forceinline__ unsigned cvt_pk_bf16(float lo, float hi) { unsigned r; asm volatile("v_cvt_pk_bf16_f32 %0, %1, %2" : "=v"(r) : "v"(lo), "v"(hi)); return r; }
struct EpiProj {
    static constexpr bool PERM = true, AFTER_DRAIN = false, HAS_MID = false;
    bf16_t* O; int ldc; const float* bias; const float *cosA, *sinA, *cosB, *sinB;
    __device__ __forceinline__ void mid(f32x4 (&)[2][2][4][2], const Unit&, int, int) const {}
    __device__ __forceinline__ void operator()(const f32x4 (&acc)[2][2][4][2], const Unit& u, int wr, int wc, int fr, int fq) const {
        typedef unsigned u32x2 __attribute__((ext_vector_type(2)));
        const int row0 = u.pm * BM + wr * 64 + fr;
#pragma unroll
        for (int bj = 0; bj < 2; ++bj) {
            const int colt = u.pn * BM + bj * HALF; int l0, l1, tst = 0, toff = 0; const float *ct = nullptr, *st = nullptr;
            if (colt < 2048) { const int jj = 4 * wc + fq; l0 = colt + 4 * jj; l1 = l0 + 64; ct = cosA; st = sinA; tst = 64; toff = 4 * jj; }
            else if (colt >= 3072 && colt < 4224) { const int jj = 4 * (wc & 1) + fq; l0 = colt + (wc >> 1) * 64 + 4 * jj; l1 = l0 + 32; ct = cosB; st = sinB; tst = 32; toff = 4 * jj; }
            else { l0 = colt + wc * 32 + 8 * fq; l1 = l0 + 4; }
            const f32x4 b0 = *(const f32x4*)(bias + l0), b1 = *(const f32x4*)(bias + l1);
#pragma unroll
            for (int ai = 0; ai < 2; ++ai)
#pragma unroll
                for (int m = 0; m < 4; ++m) { const int row = row0 + ai * HALF + m * 16; const f32x4 v0 = acc[ai][bj][m][0] + b0, v1 = acc[ai][bj][m][1] + b1; f32x4 o0 = v0, o1 = v1;
                    if (ct) { const f32x4 cv = *(const f32x4*)(ct + (size_t)row * tst + toff), sv = *(const f32x4*)(st + (size_t)row * tst + toff); o0 = v0 * cv - v1 * sv; o1 = v1 * cv + v0 * sv; }
                    bf16_t* rowp = O + (size_t)row * ldc; u32x2 w0, w1; w0.x = cvt_pk_bf16(o0[0], o0[1]); w0.y = cvt_pk_bf16(o0[2], o0[3]); w1.x = cvt_pk_bf16(o1[0], o1[1]); w1.y = cvt_pk_bf16(o1[2], o1[3]);
                    *(u32x2*)(rowp + l0) = w0; *(u32x2*)(rowp + l1) = w1; }
        }
    }
};
struct EpiRes {
    static constexpr bool PERM = false, AFTER_DRAIN = false, HAS_MID = false;
    __device__ __forceinline__ void mid(f32x4 (&)[2][2][4][2], const Unit&, int, int) const {}
    const float* base; float* out; int ldc; float alpha;
    __device__ __forceinline__ void operator()(const f32x4 (&acc)[2][2][4][2], const Unit& u, int wr, int wc, int fr, int fq) const {
        const int col0 = u.pn * BM + wc * 32 + 4 * fq;
#pragma unroll
        for (int ai = 0; ai < 2; ++ai)
#pragma unroll
            for (int m = 0; m < 4; ++m) { const size_t off = (size_t)(u.pm * BM + ai * HALF + wr * 64 + m * 16 + fr) * ldc + col0;
#pragma unroll
                for (int bj = 0; bj < 2; ++bj)
#pragma unroll
                    for (int n = 0; n < 2; ++n) { const f32x4 bs = *(const f32x4*)(base + off + bj * HALF + n * 16);
                        *(f32x4*)(out + off + bj * HALF + n * 16) = bs * alpha + acc[ai][bj][m][n]; } }
    }
};
struct EpiResRms {
    static constexpr bool PERM = false, AFTER_DRAIN = false, HAS_MID = true;
    const float* base; float* out; int ldc; float alpha; const float* ssq; int mid_t; float inv_n, eps;
    __device__ __forceinline__ void mid(f32x4 (&acc)[2][2][4][2], const Unit& u, int wr, int fr) const {
#pragma unroll
        for (int ai = 0; ai < 2; ++ai)
#pragma unroll
            for (int m = 0; m < 4; ++m) { const int row = u.pm * BM + ai * HALF + wr * 64 + m * 16 + fr; const float sa = ssq[2 * row], sb = ssq[2 * row + 1];
                const float ratio = __builtin_amdgcn_sqrtf((sb * inv_n + eps) * __builtin_amdgcn_rcpf(sa * inv_n + eps));
                asm volatile("" ::: "memory");
#pragma unroll
                for (int bj = 0; bj < 2; ++bj)
#pragma unroll
                    for (int n = 0; n < 2; ++n) acc[ai][bj][m][n] = acc[ai][bj][m][n] * ratio; }
    }
    __device__ __forceinline__ void operator()(const f32x4 (&acc)[2][2][4][2], const Unit& u, int wr, int wc, int fr, int fq) const {
        const int col0 = u.pn * BM + wc * 32 + 4 * fq;
#pragma unroll
        for (int ai = 0; ai < 2; ++ai)
#pragma unroll
            for (int m = 0; m < 4; ++m) { const int row = u.pm * BM + ai * HALF + wr * 64 + m * 16 + fr; const size_t off = (size_t)row * ldc + col0;
                const float rb = __builtin_amdgcn_rsqf(ssq[2 * row + 1] * inv_n + eps);
#pragma unroll
                for (int bj = 0; bj < 2; ++bj)
#pragma unroll
                    for (int n = 0; n < 2; ++n) { const f32x4 bs = *(const f32x4*)(base + off + bj * HALF + n * 16);
                        *(f32x4*)(out + off + bj * HALF + n * 16) = bs * alpha + acc[ai][bj][m][n] * rb; } }
    }
};
struct EpiSwiglu {
    static constexpr bool PERM = true, AFTER_DRAIN = false, HAS_MID = false;
    __device__ __forceinline__ void mid(f32x4 (&)[2][2][4][2], const Unit&, int, int) const {}
    bf16_t* O; int ldc;
    __device__ __forceinline__ void operator()(const f32x4 (&acc)[2][2][4][2], const Unit& u, int wr, int wc, int fr, int fq) const {
        const int row0 = u.pm * BM + wr * 64 + fr; const int col0 = u.pn * HALF + wc * 32 + 8 * fq;
#pragma unroll
        for (int ai = 0; ai < 2; ++ai)
#pragma unroll
            for (int m = 0; m < 4; ++m) { bf16_t* rowp = O + (size_t)(row0 + ai * HALF + m * 16) * ldc + col0;
                float hv[8];
#pragma unroll
                for (int n = 0; n < 2; ++n)
#pragma unroll
                    for (int i = 0; i < 4; ++i) { const float gt = acc[ai][0][m][n][i], up = acc[ai][1][m][n][i];
                        const float sg = __builtin_amdgcn_rcpf(1.0f + __builtin_amdgcn_exp2f(-1.44269504089f * gt));
                        hv[n * 4 + i] = gt * sg * up; }
                u32x4 w; w.x = cvt_pk_bf16(hv[0], hv[1]); w.y = cvt_pk_bf16(hv[2], hv[3]); w.z = cvt_pk_bf16(hv[4], hv[5]); w.w = cvt_pk_bf16(hv[6], hv[7]);
                *(u32x4*)rowp = w; }
    }
};

template <class Epi, class Sched, bool ALIGN_EPI = false, bool SP2 = false>
__device__ __forceinline__ void gemm_phase(PG8_LAS unsigned char* lds, const Gemm g, const Sched& S, const Epi& E) {
    int tid_ = threadIdx.x; asm volatile("" : "+v"(tid_));
    const int tid = tid_, wid = __builtin_amdgcn_readfirstlane(tid >> 6), lane = tid & 63, wr = wid >> 2, wc = wid & 3, fr = lane & 15, fq = lane >> 4;
    const int K = g.K, nt = K / BK;
    unsigned voffA[2], voffB[2];
#pragma unroll
    for (int i = 0; i < 2; ++i) { int R, C; stage_rc(tid * 16 + i * 8192, R, C); const int Rb = Epi::PERM ? ((R & ~31) + perm32(R & 31)) : R;
        voffA[i] = (unsigned)(R * K + C) * 2u; voffB[i] = (unsigned)(Rb * K + C) * 2u; }
    const size_t kstep = (size_t)(BK * 2);
    const size_t hstep = (size_t)HALF * K * 2;
    const size_t tstep = 2 * hstep;
    const unsigned ldsw = (unsigned)wid * 1024u;
    const int aoff = lds_byte(wr * 64 + fr, fq * 8), boff = lds_byte(wc * 32 + fr, fq * 8);
#define PG8_SA(b, h) (((b) * 2 + (h)) * HTB)
#define PG8_SB(b, h) ((4 + (b) * 2 + (h)) * HTB)
#define PG8_STAGE(bufoff, gbase, voff) do { _Pragma("unroll") for (int _i = 0; _i < 2; ++_i) \
        __builtin_amdgcn_global_load_lds((const unsigned*)((const char*)(gbase) + (voff)[_i]), (PG8_LAS unsigned*)(lds + (bufoff) + ldsw + _i * 8192), 16, 0, 0); } while (0)
#define PG8_LDA(dst, b, h) do { _Pragma("unroll") for (int m = 0; m < 4; ++m) _Pragma("unroll") for (int k = 0; k < 2; ++k) dst[m][k] = *(const PG8_LAS bf16x8*)(lds + PG8_SA(b, h) + aoff + m * 2048 + k * 1024); } while (0)
#define PG8_LDB(dst, b, h) do { _Pragma("unroll") for (int n = 0; n < 2; ++n) _Pragma("unroll") for (int k = 0; k < 2; ++k) dst[n][k] = *(const PG8_LAS bf16x8*)(lds + PG8_SB(b, h) + boff + n * 2048 + k * 1024); } while (0)
#define PG8_MMA(ai, bj, At, Bt) do { __builtin_amdgcn_s_setprio(1); _Pragma("unroll") for (int m = 0; m < 4; ++m) _Pragma("unroll") for (int n = 0; n < 2; ++n) _Pragma("unroll") for (int k = 0; k < 2; ++k) \
        acc[ai][bj][m][n] = __builtin_amdgcn_mfma_f32_16x16x32_bf16(Bt[n][k], At[m][k], acc[ai][bj][m][n], 0, 0, 0); __builtin_amdgcn_s_setprio(0); } while (0)
#define PG8_WAIT_V(n) asm volatile("s_waitcnt vmcnt(" #n ")" ::: "memory")
#define PG8_WAIT_L(n) asm volatile("s_waitcnt lgkmcnt(" #n ")" ::: "memory")
#define PG8_BAR __builtin_amdgcn_s_barrier()
#define PG8_SCHED __builtin_amdgcn_sched_barrier(0)
    Unit cur, nxt; int ui = 0;
    if (!S.next(0, cur)) return;
    f32x4 acc[2][2][4][2];
#pragma unroll
    for (int a = 0; a < 2; ++a)
#pragma unroll
        for (int b = 0; b < 2; ++b)
#pragma unroll
            for (int m = 0; m < 4; ++m)
#pragma unroll
                for (int n = 0; n < 2; ++n) acc[a][b][m][n] = (f32x4){0.f, 0.f, 0.f, 0.f};
    bf16x8 At[4][2], B0[2][2], B1[2][2];
    const char* cA = (const char*)g.A + (size_t)cur.pm * tstep; const char* cB = (const char*)g.Bt + (size_t)cur.pn * tstep;
    S.a_ready(cur);
    if constexpr (SP2) {
        PG8_STAGE(PG8_SB(0, 0), cB, voffB); PG8_STAGE(PG8_SB(0, 1), cB + hstep, voffB); PG8_STAGE(PG8_SA(0, 0), cA, voffA); PG8_STAGE(PG8_SA(0, 1), cA + hstep, voffA);
        if (wr == 1) PG8_BAR;
        PG8_WAIT_V(2); PG8_BAR;
        PG8_STAGE(PG8_SB(1, 0), cB + kstep, voffB); PG8_STAGE(PG8_SA(1, 0), cA + kstep, voffA); PG8_STAGE(PG8_SB(1, 1), cB + hstep + kstep, voffB);
        PG8_WAIT_V(6); PG8_BAR;
    } else {
        PG8_STAGE(PG8_SB(0, 0), cB, voffB); PG8_STAGE(PG8_SA(0, 0), cA, voffA); PG8_STAGE(PG8_SB(0, 1), cB + hstep, voffB); PG8_STAGE(PG8_SA(0, 1), cA + hstep, voffA);
        if (wr == 1) PG8_BAR;
        PG8_WAIT_V(4); PG8_BAR;
        PG8_STAGE(PG8_SB(1, 0), cB + kstep, voffB); PG8_STAGE(PG8_SA(1, 0), cA + kstep, voffA); PG8_STAGE(PG8_SB(1, 1), cB + hstep + kstep, voffB);
        PG8_WAIT_V(6); PG8_BAR;
    }
    for (;;) {
        const bool has_next = S.next(ui + 1, nxt);
        const char* nA = has_next ? (const char*)g.A + (size_t)nxt.pm * tstep : cA; const char* nB = has_next ? (const char*)g.Bt + (size_t)nxt.pn * tstep : cB;
        for (int t = 0; t < nt; t += 2) {
            const bool last = (t == nt - 2);
            const char* a1 = cA + (size_t)(t + 1) * kstep;
            const char* a2 = last ? nA : cA + (size_t)(t + 2) * kstep; const char* b2 = last ? nB : cB + (size_t)(t + 2) * kstep;
            const char* a3 = a2 + kstep; const char* b3 = b2 + kstep;
            if (last && has_next) S.a_ready(nxt);
            if constexpr (Epi::HAS_MID) { if (t == E.mid_t) E.mid(acc, cur, wr, fr); }
            if constexpr (SP2) {
            PG8_LDB(B0, 0, 0); PG8_LDB(B1, 0, 1); PG8_SCHED; PG8_LDA(At, 0, 0); PG8_STAGE(PG8_SA(1, 1), a1 + hstep, voffA);
            PG8_WAIT_V(8); PG8_WAIT_L(0); PG8_BAR; PG8_MMA(0, 0, At, B0); PG8_MMA(0, 1, At, B1); PG8_BAR; PG8_SCHED;
            PG8_LDA(At, 0, 1); PG8_STAGE(PG8_SB(0, 0), b2, voffB); PG8_STAGE(PG8_SB(0, 1), b2 + hstep, voffB); PG8_STAGE(PG8_SA(0, 0), a2, voffA);
            PG8_WAIT_V(8); PG8_WAIT_L(0); PG8_BAR; PG8_MMA(1, 0, At, B0); PG8_MMA(1, 1, At, B1); PG8_BAR; PG8_SCHED;
            PG8_LDB(B0, 1, 0); PG8_LDB(B1, 1, 1); PG8_SCHED; PG8_LDA(At, 1, 0); PG8_STAGE(PG8_SA(0, 1), a2 + hstep, voffA);
            PG8_WAIT_V(8); PG8_WAIT_L(0); PG8_BAR; PG8_MMA(0, 0, At, B0); PG8_MMA(0, 1, At, B1); PG8_BAR; PG8_SCHED;
            PG8_LDA(At, 1, 1); PG8_STAGE(PG8_SB(1, 0), b3, voffB); PG8_STAGE(PG8_SB(1, 1), b3 + hstep, voffB); PG8_STAGE(PG8_SA(1, 0), a3, voffA);
            PG8_WAIT_V(8); PG8_WAIT_L(0); PG8_BAR; PG8_MMA(1, 0, At, B0); PG8_MMA(1, 1, At, B1); PG8_BAR; PG8_SCHED;
            } else {
            PG8_LDB(B0, 0, 0); PG8_SCHED; PG8_LDA(At, 0, 0); PG8_STAGE(PG8_SA(1, 1), a1 + hstep, voffA);
            PG8_WAIT_L(8); PG8_BAR; PG8_WAIT_L(0); PG8_MMA(0, 0, At, B0); PG8_BAR; PG8_SCHED;
            PG8_LDB(B1, 0, 1); PG8_STAGE(PG8_SB(0, 0), b2, voffB);
            PG8_BAR; PG8_WAIT_L(0); PG8_MMA(0, 1, At, B1); PG8_BAR;
            PG8_LDA(At, 0, 1); PG8_STAGE(PG8_SA(0, 0), a2, voffA);
            PG8_BAR; PG8_WAIT_L(0); PG8_MMA(1, 0, At, B0); PG8_BAR; PG8_SCHED;
            PG8_STAGE(PG8_SB(0, 1), b2 + hstep, voffB);
            PG8_WAIT_V(6); PG8_BAR; PG8_MMA(1, 1, At, B1); PG8_BAR;
            PG8_LDB(B0, 1, 0); PG8_SCHED; PG8_LDA(At, 1, 0); PG8_STAGE(PG8_SA(0, 1), a2 + hstep, voffA);
            PG8_WAIT_L(8); PG8_BAR; PG8_WAIT_L(0); PG8_MMA(0, 0, At, B0); PG8_BAR; PG8_SCHED;
            PG8_LDB(B1, 1, 1); PG8_STAGE(PG8_SB(1, 0), b3, voffB);
            PG8_BAR; PG8_WAIT_L(0); PG8_MMA(0, 1, At, B1); PG8_BAR;
            PG8_LDA(At, 1, 1); PG8_STAGE(PG8_SA(1, 0), a3, voffA);
            PG8_BAR; PG8_WAIT_L(0); PG8_MMA(1, 0, At, B0); PG8_BAR; PG8_SCHED;
            PG8_STAGE(PG8_SB(1, 1), b3 + hstep, voffB);
            PG8_WAIT_V(6); PG8_BAR; PG8_MMA(1, 1, At, B1); PG8_BAR;
            }
        }
        if constexpr (ALIGN_EPI) { if (wr == 0) PG8_BAR; }
        if constexpr (!Epi::AFTER_DRAIN) { E(acc, cur, wr, wc, fr, fq); S.done(cur); }
        if (!has_next) break;
#pragma unroll
        for (int a = 0; a < 2; ++a)
#pragma unroll
            for (int b = 0; b < 2; ++b)
#pragma unroll
                for (int m = 0; m < 4; ++m)
#pragma unroll
                    for (int n = 0; n < 2; ++n) acc[a][b][m][n] = (f32x4){0.f, 0.f, 0.f, 0.f};
        cur = nxt; cA = nA; cB = nB; ++ui;
        if constexpr (ALIGN_EPI) { if (wr == 1) PG8_BAR; }
    }
    PG8_WAIT_V(0);
    if constexpr (!ALIGN_EPI) { if (wr == 0) PG8_BAR; }
    PG8_BAR;
    if constexpr (Epi::AFTER_DRAIN) { E.fused(acc, cur, wr, wc, fr, fq, lds, wid, lane); S.done(cur); }
#undef PG8_SA
#undef PG8_SB
#undef PG8_STAGE
#undef PG8_LDA
#undef PG8_LDB
#undef PG8_MMA
#undef PG8_WAIT_V
#undef PG8_WAIT_L
#undef PG8_BAR
#undef PG8_SCHED
}
}

namespace cg = cooperative_groups;
#define GAS __attribute__((address_space(1)))
#define LAS __attribute__((address_space(3)))
typedef unsigned short bf16;
typedef unsigned v4u __attribute__((ext_vector_type(4)));
typedef unsigned v2u __attribute__((ext_vector_type(2)));
typedef float f32x4 __attribute__((ext_vector_type(4)));
typedef short bf16x8 __attribute__((ext_vector_type(8)));
typedef short s16x4 __attribute__((ext_vector_type(4)));

constexpr int NWAVES = 8, NTHREADS = NWAVES * 64;
constexpr int S = 16384, DM = 2048, INW = 4352, DFF = 5632, NUP = 2 * DFF;
constexpr int QA_OFF = 0, KA_OFF = 1024, VA_OFF = 2048, QB_OFF = 3072, KB_OFF = 4096, VB_OFF = 4224;
constexpr float ALPHA = 1.189207115002721f;
constexpr float LN_EPS = 1e-5f, RMS_EPS = 1e-6f;
constexpr int LDS_BYTES = 147456;

constexpr size_t MiB = 1u << 20;
constexpr size_t WS_SSQ = 0;
constexpr size_t WS_COSA = 1 * MiB, WS_SINA = 5 * MiB, WS_COSB = 9 * MiB, WS_SINB = 11 * MiB;
constexpr size_t WS_WI = 16 * MiB, WS_WO = 33 * MiB, WS_WU = 41 * MiB, WS_WD = 85 * MiB;
constexpr size_t WS_XB = 108 * MiB;
constexpr size_t WS_PROJ = 172 * MiB;
constexpr size_t WS_Y = 308 * MiB;
constexpr size_t WS_H = 172 * MiB;
constexpr size_t WS_END = 372 * MiB;
static_assert(WS_WI + (size_t)INW * DM * 2 <= WS_WO && WS_WO + (size_t)DM * DM * 2 <= WS_WU && WS_WU + (size_t)NUP * DM * 2 <= WS_WD && WS_WD + (size_t)DM * DFF * 2 <= WS_XB, "ws map (weights)");
static_assert(WS_XB + (size_t)S * DM * 2 <= WS_PROJ && WS_PROJ + (size_t)S * INW * 2 <= WS_Y && WS_Y + (size_t)S * DM * 2 <= WS_END && WS_H + (size_t)S * DFF * 2 <= WS_END, "ws map (activations)");

__device__ __forceinline__ unsigned f2bf(float f) { unsigned u = __builtin_bit_cast(unsigned, f); return (u + 0x7fffu + ((u >> 16) & 1u)) >> 16; }
__device__ __forceinline__ unsigned pk2(float lo, float hi) { return f2bf(lo) | (f2bf(hi) << 16); }
__device__ __forceinline__ float bflo(unsigned w) { return __builtin_bit_cast(float, w << 16); }
__device__ __forceinline__ float bfhi(unsigned w) { return __builtin_bit_cast(float, w & 0xffff0000u); }
#define LDS_WAIT() asm volatile("s_waitcnt lgkmcnt(0)" ::: "memory")

__device__ __forceinline__ float wave_sum(float v) {
#pragma unroll
    for (int o = 1; o < 64; o <<= 1) v += __shfl_xor(v, o);
    return v;
}

__device__ __forceinline__ void p0_transpose_item(const float* W, int K, int N, bf16* WT, int k0, int n0, int drow0, bool perm, const float* gk, LAS float* scr, int lane) {
#pragma unroll 8
    for (int i = 0; i < 32; ++i) { const int kk = 2 * i + (lane >> 5); float w = W[(size_t)(k0 + kk) * N + n0 + (lane & 31)]; if (gk) w *= gk[k0 + kk]; scr[kk * 33 + (lane & 31)] = w; }
    LDS_WAIT(); asm volatile("" ::: "memory");
    const int c = lane & 7;
#pragma unroll
    for (int j = 0; j < 4; ++j) { const int n = (lane >> 3) + 8 * j; const LAS float* s = scr + (8 * c) * 33 + n; const int dr = drow0 + (perm ? 8 * (n >> 2) + (n & 3) : n);
        v4u o; o.x = pk2(s[0 * 33], s[1 * 33]); o.y = pk2(s[2 * 33], s[3 * 33]); o.z = pk2(s[4 * 33], s[5 * 33]); o.w = pk2(s[6 * 33], s[7 * 33]);
        *(v4u*)(WT + (size_t)dr * K + k0 + 8 * c) = o; }
    LDS_WAIT(); asm volatile("" ::: "memory");
}

struct Args { const float* in[13]; float* out; unsigned char* ws; };

__device__ __forceinline__ void phase_prologue(const Args& a, LAS unsigned char* lds, int gw, int NGW, int lane, int wave) {
    unsigned char* ws = a.ws;
    LAS float* scr = (LAS float*)(lds + wave * 16384);
    const float* w_in = a.in[1]; const float* w_out = a.in[6]; const float* w_up = a.in[9]; const float* w_down = a.in[10];
    bf16* Wi = (bf16*)(ws + WS_WI); bf16* Wo = (bf16*)(ws + WS_WO); bf16* Wu = (bf16*)(ws + WS_WU); bf16* Wd = (bf16*)(ws + WS_WD);
    constexpr int I_IN = (DM / 64) * (INW / 32), I_OUT = (DM / 64) * (DM / 32), I_UP = (DM / 64) * (NUP / 32), I_DN = (DFF / 64) * (DM / 32);
    constexpr int NITEMS = I_IN + I_OUT + I_UP + I_DN;
    for (int it = gw; it < NITEMS; it += NGW) {
        int r = it;
        if (r < I_IN) { const int nb = INW / 32, kb = r / nb, n0 = (r % nb) * 32; int dr = n0; bool pm = false;
            if (n0 < 2048) { const int d0 = n0 & 127; dr = (n0 & ~127) + 2 * (d0 & 63) + 4 * (d0 >> 6); pm = true; }
            else if (n0 >= QB_OFF && n0 < VB_OFF) { const int d0 = n0 & 63; dr = (n0 & ~63) + 4 * (d0 >> 5); pm = true; }
            p0_transpose_item(w_in, DM, INW, Wi, kb * 64, n0, dr, pm, nullptr, scr, lane); continue; } r -= I_IN;
        if (r < I_OUT) { const int nb = DM / 32, kb = r / nb, n0 = (r % nb) * 32; p0_transpose_item(w_out, DM, DM, Wo, kb * 64, n0, n0, false, (kb * 64 < 1024) ? a.in[4] : a.in[5] - 1024, scr, lane); continue; } r -= I_OUT;
        if (r < I_UP) { const int nb = NUP / 32, kb = r / nb, n0 = (r % nb) * 32; const int half = n0 / DFF, rem = n0 % DFF;
            p0_transpose_item(w_up, DM, NUP, Wu, kb * 64, n0, 256 * (rem / 128) + 128 * half + (rem % 128), false, nullptr, scr, lane); continue; } r -= I_UP;
        { const int nb = DM / 32, kb = r / nb, n0 = (r % nb) * 32; p0_transpose_item(w_down, DFF, DM, Wd, kb * 64, n0, n0, false, nullptr, scr, lane); }
    }
    const int gt = gw * 64 + lane, NGT = NGW * 64;
    { const f32x4* x4 = (const f32x4*)a.in[0]; v4u* xb = (v4u*)(ws + WS_XB);
      for (int i = gt; i < S * DM / 8; i += NGT) { const f32x4 p = x4[2 * i], q = x4[2 * i + 1]; v4u o; o.x = pk2(p[0], p[1]); o.y = pk2(p[2], p[3]); o.z = pk2(q[0], q[1]); o.w = pk2(q[2], q[3]); xb[i] = o; } }
    { float* cA = (float*)(ws + WS_COSA); float* sA = (float*)(ws + WS_SINA); float* cB = (float*)(ws + WS_COSB); float* sB = (float*)(ws + WS_SINB);
      for (int i = gt; i < S * 96; i += NGT) { const int pos = i / 96, j = i % 96; const bool isA = j < 64; const int jj = isA ? j : j - 64;
          const double e = -(double)jj * (isA ? (13.287712379549449 / 64.0) : (13.287712379549449 / 32.0));
          const double inv = exp2(e); double turns = (double)pos * inv * 0.15915494309189535; turns -= floor(turns);
          const float fr = (float)turns; const float cv = __builtin_amdgcn_cosf(fr), sv = __builtin_amdgcn_sinf(fr);
          if (isA) { cA[pos * 64 + jj] = cv; sA[pos * 64 + jj] = sv; } else { cB[pos * 32 + jj] = cv; sB[pos * 32 + jj] = sv; } } }
    { float* ssq = (float*)(ws + WS_SSQ); for (int i = gt; i < S * 2; i += NGT) ssq[i] = 0.f; }
}

__device__ __forceinline__ void phase_rope(const Args& a, int gt, int NGT) {
    unsigned char* ws = a.ws; bf16* proj = (bf16*)(ws + WS_PROJ);
    const float* cA = (const float*)(ws + WS_COSA); const float* sA = (const float*)(ws + WS_SINA); const float* cB = (const float*)(ws + WS_COSB); const float* sB = (const float*)(ws + WS_SINB);
    for (int it = gt; it < S * 200; it += NGT) {
        const int pos = it / 200, i = it % 200; int col, pcol; const float *ct, *st;
        if (i < 128) { col = (i >> 3) * 128 + (i & 7) * 8; pcol = col + 64; ct = cA + pos * 64 + (i & 7) * 8; st = sA + pos * 64 + (i & 7) * 8; }
        else { const int j = i - 128; col = QB_OFF + (j >> 2) * 64 + (j & 3) * 8; pcol = col + 32; ct = cB + pos * 32 + (j & 3) * 8; st = sB + pos * 32 + (j & 3) * 8; }
        v4u* p1 = (v4u*)(proj + (size_t)pos * INW + col); v4u* p2 = (v4u*)(proj + (size_t)pos * INW + pcol);
        const v4u u1 = *p1, u2 = *p2; const f32x4 c0 = *(const f32x4*)ct, c1 = *(const f32x4*)(ct + 4), s0 = *(const f32x4*)st, s1 = *(const f32x4*)(st + 4);
        v4u o1, o2;
#pragma unroll
        for (int e = 0; e < 4; ++e) { const float xa = bflo(u1[e]), xb = bfhi(u1[e]), ya = bflo(u2[e]), yb = bfhi(u2[e]);
            const float ca = e < 2 ? c0[2 * e] : c1[2 * e - 4], cb = e < 2 ? c0[2 * e + 1] : c1[2 * e - 3], sa = e < 2 ? s0[2 * e] : s1[2 * e - 4], sb = e < 2 ? s0[2 * e + 1] : s1[2 * e - 3];
            o1[e] = pk2(xa * ca - ya * sa, xb * cb - yb * sb); o2[e] = pk2(ya * ca + xa * sa, yb * cb + xb * sb); }
        *p1 = o1; *p2 = o2;
    }
}

namespace att {
constexpr int VROW = 288, KROW = 272, VBUF = 32 * VROW, KBUF = 32 * KROW, WBUF = VBUF + KBUF;
__device__ __forceinline__ s16x4 vtr(const LAS unsigned char* p) { typedef short v4i16_t __attribute__((ext_vector_type(4)));
    return __builtin_bit_cast(s16x4, __builtin_amdgcn_ds_read_tr16_b64_v4i16((LAS v4i16_t*)p)); }
__device__ __forceinline__ unsigned cvtpk(float lo, float hi) { unsigned r; asm volatile("v_cvt_pk_bf16_f32 %0, %1, %2" : "=v"(r) : "v"(lo), "v"(hi)); return r; }

template <int D> struct KVS { bf16x8 k[D / 16]; bf16x8 v[D / 16]; };

template <int D>
__device__ __forceinline__ void load_kv(KVS<D>& t, const bf16* kcol, const bf16* vcol, int kbase, int dil, int b, int lane) {
    constexpr int CPR = D / 8;
#pragma unroll
    for (int i = 0; i < D / 16; ++i) { const int n = lane + 64 * i, row = n / CPR, ch = n % CPR; int kp = kbase + dil * (32 * b + row); kp = kp < 0 ? 0 : (kp > S - 1 ? S - 1 : kp);
        const size_t ro = (size_t)kp * INW + 8 * ch; t.k[i] = *(const bf16x8*)(kcol + ro); t.v[i] = *(const bf16x8*)(vcol + ro); }
}

template <int D>
__device__ __forceinline__ void span(f32x4 (&o)[D / 16], float& m, float& l, const bf16x8 (&qf)[D / 32], const bf16* kcol, const bf16* vcol,
                                     int kbase, int dil, int nblk, int tqrel, int maxdist, float sc, LAS unsigned char* kl, LAS unsigned char* vl, int lane) {
    const int c = lane & 15, g = lane >> 4, q4 = (lane & 15) >> 2, p4 = lane & 3;
    constexpr int CPR = D / 8;
    KVS<D> st;
    load_kv<D>(st, kcol, vcol, kbase, dil, 0, lane);
    for (int b = 0; b < nblk; ++b) {
#pragma unroll
        for (int i = 0; i < D / 16; ++i) { const int n = lane + 64 * i, row = n / CPR, ch = n % CPR; *(LAS bf16x8*)(kl + row * KROW + ch * 16) = st.k[i]; *(LAS bf16x8*)(vl + row * VROW + ch * 16) = st.v[i]; }
        if (b + 1 < nblk) load_kv<D>(st, kcol, vcol, kbase, dil, b + 1, lane);
        f32x4 a0 = {0.f, 0.f, 0.f, 0.f}, a1 = {0.f, 0.f, 0.f, 0.f};
#pragma unroll
        for (int ks = 0; ks < D / 32; ++ks) { const bf16x8 k0 = *(const LAS bf16x8*)(kl + c * KROW + 64 * ks + 16 * g), k1 = *(const LAS bf16x8*)(kl + (16 + c) * KROW + 64 * ks + 16 * g);
            a0 = __builtin_amdgcn_mfma_f32_16x16x32_bf16(k0, qf[ks], a0, 0, 0, 0); a1 = __builtin_amdgcn_mfma_f32_16x16x32_bf16(k1, qf[ks], a1, 0, 0, 0); }
        float s[8];
#pragma unroll
        for (int e = 0; e < 8; ++e) { const int jj = 32 * b + 16 * (e >> 2) + 4 * g + (e & 3); const int dist = tqrel - dil * jj; const bool ok = ((unsigned)dist <= (unsigned)maxdist) && (kbase + dil * jj >= 0);
            const float v = (e < 4 ? a0[e & 3] : a1[e & 3]) * sc; s[e] = ok ? v : -INFINITY; }
        float ml = fmaxf(fmaxf(fmaxf(s[0], s[1]), fmaxf(s[2], s[3])), fmaxf(fmaxf(s[4], s[5]), fmaxf(s[6], s[7])));
        ml = fmaxf(ml, __shfl_xor(ml, 16)); ml = fmaxf(ml, __shfl_xor(ml, 32));
        const float mn = fmaxf(m, ml); const float ms = (mn == -INFINITY) ? 0.f : mn;
        const float alpha = __builtin_amdgcn_exp2f(m - ms);
        float p[8], ps = 0.f;
#pragma unroll
        for (int e = 0; e < 8; ++e) { p[e] = __builtin_amdgcn_exp2f(s[e] - ms); ps += p[e]; }
        l = l * alpha + ps; m = mn;
#pragma unroll
        for (int nt = 0; nt < D / 16; ++nt) o[nt] = o[nt] * alpha;
        v4u pw; pw.x = cvtpk(p[0], p[1]); pw.y = cvtpk(p[2], p[3]); pw.z = cvtpk(p[4], p[5]); pw.w = cvtpk(p[6], p[7]);
        const bf16x8 pf = __builtin_bit_cast(bf16x8, pw);
#pragma unroll
        for (int nt = 0; nt < D / 16; ++nt) {
            const s16x4 r1 = vtr(vl + (4 * g + q4) * VROW + (16 * nt + 4 * p4) * 2), r2 = vtr(vl + (16 + 4 * g + q4) * VROW + (16 * nt + 4 * p4) * 2);
            bf16x8 vf; vf[0] = r1[0]; vf[1] = r1[1]; vf[2] = r1[2]; vf[3] = r1[3]; vf[4] = r2[0]; vf[5] = r2[1]; vf[6] = r2[2]; vf[7] = r2[3];
            o[nt] = __builtin_amdgcn_mfma_f32_16x16x32_bf16(vf, pf, o[nt], 0, 0, 0);
        }
    }
}

template <int D>
__device__ __forceinline__ void finish(const f32x4 (&o)[D / 16], float ltot, bf16* yrow  , float* ssqp, int lane) {
    const float inv = 1.0f / ltot; float sq = 0.f;
#pragma unroll
    for (int nt = 0; nt < D / 16; ++nt) { const f32x4 v = o[nt] * inv; sq += (v[0] * v[0] + v[1] * v[1]) + (v[2] * v[2] + v[3] * v[3]);
        v2u w; w.x = cvtpk(v[0], v[1]); w.y = cvtpk(v[2], v[3]); *(v2u*)(yrow + 16 * nt) = w; }
    sq += __shfl_xor(sq, 16); sq += __shfl_xor(sq, 32);
    if ((lane >> 4) == 0) atomicAdd(ssqp, sq);
}
}

__device__ __forceinline__ void phase_attention(const Args& a, LAS unsigned char* lds, int gw, int NGW, int lane, int wave) {
    unsigned char* ws = a.ws; const bf16* proj = (const bf16*)(ws + WS_PROJ); bf16* Y = (bf16*)(ws + WS_Y); float* ssq = (float*)(ws + WS_SSQ);
    const float* sinks = a.in[3];
    LAS unsigned char* vl = lds + wave * att::WBUF; LAS unsigned char* kl = vl + att::VBUF;
    const int c = lane & 15, g = lane >> 4;
    const int G_ = NGW / NWAVES; const bool xa = (G_ % 8) == 0; const int wpx = xa ? (G_ / 8) * NWAVES : NGW;
    const int ti0 = xa ? ((int)(blockIdx.x >> 3) * NWAVES + wave) : gw; const int nti = xa ? 1024 : 8 * 1024;
    for (int ti = ti0; ti < nti; ti += wpx) {
        const int t = xa ? (((int)blockIdx.x & 7) << 10) + ti : ti;
        const int r = t & 15, mb = (t >> 4) & 63, h = t >> 10; const int t0 = r + 256 * mb, tq = t0 + 16 * c;
        bf16x8 qf[4];
#pragma unroll
        for (int ks = 0; ks < 4; ++ks) qf[ks] = *(const bf16x8*)(proj + (size_t)tq * INW + QA_OFF + h * 128 + 32 * ks + 8 * g);
        f32x4 o[8];
#pragma unroll
        for (int nt = 0; nt < 8; ++nt) o[nt] = (f32x4){0.f, 0.f, 0.f, 0.f};
        float m = -INFINITY, l = 0.f;
        const bf16* kcol = proj + KA_OFF + h * 128; const bf16* vcol = proj + VA_OFF + h * 128;
        const float sc = 1.44269504089f * 0.08838834764831845f;
        att::span<128>(o, m, l, qf, kcol, vcol, t0 - 128, 1, 12, 16 * c + 128, 128, sc, kl, vl, lane);
        att::span<128>(o, m, l, qf, kcol, vcol, t0 - 512, 4, 6, 16 * c + 512, 512, sc, kl, vl, lane);
        att::span<128>(o, m, l, qf, kcol, vcol, t0 - 2048, 16, 5, 16 * c + 2048, 2048, sc, kl, vl, lane);
        float lt = l; lt += __shfl_xor(lt, 16); lt += __shfl_xor(lt, 32);
        att::finish<128>(o, lt, Y + (size_t)tq * DM + h * 128 + 4 * g, ssq + 2 * tq, lane);
    }
    for (int t = gw; t < 16 * 1024; t += NGW) {
        const int hl = t & 7, pb = (t >> 3) & 1023, kvh = t >> 13, hq = kvh * 8 + hl; const int tq = 16 * pb + c;
        bf16x8 qf[2];
#pragma unroll
        for (int ks = 0; ks < 2; ++ks) qf[ks] = *(const bf16x8*)(proj + (size_t)tq * INW + QB_OFF + hq * 64 + 32 * ks + 8 * g);
        f32x4 o[4];
#pragma unroll
        for (int nt = 0; nt < 4; ++nt) o[nt] = (f32x4){0.f, 0.f, 0.f, 0.f};
        float m = -INFINITY, l = 0.f;
        const bf16* kcol = proj + KB_OFF + kvh * 64; const bf16* vcol = proj + VB_OFF + kvh * 64;
        att::span<64>(o, m, l, qf, kcol, vcol, 16 * pb - 128, 1, 5, c + 128, 127, 1.44269504089f * 0.125f, kl, vl, lane);
        float lt = l; lt += __shfl_xor(lt, 16); lt += __shfl_xor(lt, 32);
        lt += __builtin_amdgcn_exp2f(sinks[hq] * 1.44269504089f - m);
        att::finish<64>(o, lt, Y + (size_t)tq * DM + 1024 + hq * 64 + 4 * g, ssq + 2 * tq + 1, lane);
    }
}

__device__ __forceinline__ void phase_rms(const Args& a, int gt, int NGT) {
    unsigned char* ws = a.ws; v4u* Y = (v4u*)(ws + WS_Y); const float* ssq = (const float*)(ws + WS_SSQ);
    const float* ga = a.in[4]; const float* gb = a.in[5];
    for (int i = gt; i < S * DM / 8; i += NGT) { const int pos = i >> 8, c8 = (i & 255) * 8; const int grp = c8 >> 10;
        const float rs = 1.0f / sqrtf(ssq[2 * pos + grp] * (1.0f / 1024.0f) + RMS_EPS);
        const float* gp = grp ? gb + (c8 - 1024) : ga + c8; const f32x4 g0 = *(const f32x4*)gp, g1 = *(const f32x4*)(gp + 4);
        const v4u u = Y[i]; v4u o;
        o.x = pk2(bflo(u.x) * rs * g0[0], bfhi(u.x) * rs * g0[1]); o.y = pk2(bflo(u.y) * rs * g0[2], bfhi(u.y) * rs * g0[3]);
        o.z = pk2(bflo(u.z) * rs * g1[0], bfhi(u.z) * rs * g1[1]); o.w = pk2(bflo(u.w) * rs * g1[2], bfhi(u.w) * rs * g1[3]);
        Y[i] = o; }
}

__device__ __forceinline__ void phase_ln(float* buf, const float* gam, const float* bet, bf16* xb, int gw, int NGW, int lane) {
    for (int row = gw; row < S; row += NGW) {
        f32x4* xr = (f32x4*)(buf + (size_t)row * DM) + lane;
        f32x4 v[8]; float s = 0.f;
#pragma unroll
        for (int j = 0; j < 8; ++j) { v[j] = xr[64 * j]; s += (v[j][0] + v[j][1]) + (v[j][2] + v[j][3]); }
        const float mean = wave_sum(s) * (1.f / DM); float s2 = 0.f;
#pragma unroll
        for (int j = 0; j < 8; ++j) { v[j] = v[j] - mean; s2 += (v[j][0] * v[j][0] + v[j][1] * v[j][1]) + (v[j][2] * v[j][2] + v[j][3] * v[j][3]); }
        const float rstd = 1.f / sqrtf(wave_sum(s2) * (1.f / DM) + LN_EPS);
#pragma unroll
        for (int j = 0; j < 8; ++j) { const f32x4 gg = *((const f32x4*)gam + lane + 64 * j), bb = *((const f32x4*)bet + lane + 64 * j);
            const f32x4 ov = v[j] * rstd * gg + bb; xr[64 * j] = ov;
            if (xb) { v2u w; w.x = pk2(ov[0], ov[1]); w.y = pk2(ov[2], ov[3]); *((v2u*)(xb + (size_t)row * DM) + lane + 64 * j) = w; } }
    }
}

__global__ void __launch_bounds__(NTHREADS, 2) hymba_fwd(Args args) {
    extern __shared__ __attribute__((aligned(16))) unsigned char lds_raw[];
    LAS unsigned char* lds = (LAS unsigned char*)lds_raw;
    cg::grid_group grid = cg::this_grid();
    const int tid = threadIdx.x, lane = tid & 63, wave = __builtin_amdgcn_readfirstlane(tid >> 6);
    const int G = gridDim.x, gw = blockIdx.x * NWAVES + wave, NGW = G * NWAVES, gt = blockIdx.x * NTHREADS + tid, NGT = G * NTHREADS;
    unsigned char* ws = args.ws;
    bf16* Wi = (bf16*)(ws + WS_WI); bf16* Wo = (bf16*)(ws + WS_WO); bf16* Wu = (bf16*)(ws + WS_WU); bf16* Wd = (bf16*)(ws + WS_WD);
    bf16* XB = (bf16*)(ws + WS_XB); bf16* PROJ = (bf16*)(ws + WS_PROJ); bf16* Y = (bf16*)(ws + WS_Y); bf16* H = (bf16*)(ws + WS_H);

    phase_prologue(args, lds, gw, NGW, lane, wave);
    grid.sync();
    {
        pg8::Gemm g{XB, Wi, S, INW, DM}; pg8::StaticOrder So; So.init(S, INW, G, (int)blockIdx.x);
        pg8::EpiProj E{PROJ, INW, args.in[2], (const float*)(ws + WS_COSA), (const float*)(ws + WS_SINA), (const float*)(ws + WS_COSB), (const float*)(ws + WS_SINB)};
        pg8::gemm_phase<pg8::EpiProj, pg8::StaticOrder, true, true>(lds, g, So, E);
    }
    grid.sync();
    phase_attention(args, lds, gw, NGW, lane, wave);
    grid.sync();
    {
        pg8::Gemm g{Y, Wo, S, DM, DM}; pg8::StaticOrder So; So.init(S, DM, G, (int)blockIdx.x);
        pg8::EpiResRms E{args.in[0], args.out, DM, ALPHA, (const float*)(ws + WS_SSQ), 16, 1.0f / 1024.0f, RMS_EPS};
        pg8::gemm_phase<pg8::EpiResRms, pg8::StaticOrder, true, true>(lds, g, So, E);
    }
    grid.sync();
    phase_ln(args.out, args.in[7], args.in[8], XB, gw, NGW, lane);
    grid.sync();
    {
        pg8::Gemm g{XB, Wu, S, NUP, DM}; pg8::StaticOrder So; So.init(S, NUP, G, (int)blockIdx.x);
        pg8::EpiSwiglu E{H, DFF};
        pg8::gemm_phase<pg8::EpiSwiglu, pg8::StaticOrder, true, true>(lds, g, So, E);
    }
    grid.sync();
    {
        pg8::Gemm g{H, Wd, S, DM, DFF}; pg8::StaticOrder So; So.init(S, DM, G, (int)blockIdx.x);
        pg8::EpiRes E{args.out, args.out, DM, ALPHA};
        pg8::gemm_phase<pg8::EpiRes, pg8::StaticOrder, true, true>(lds, g, So, E);
    }
    grid.sync();
    phase_ln(args.out, args.in[11], args.in[12], nullptr, gw, NGW, lane);
}

extern "C" void kernel_launch(void* const* d_in, const int* in_sizes, int n_in, void* d_out, int out_size, void* d_ws, size_t ws_size, hipStream_t stream) {
    static int grid = 0;
    if (grid == 0) {
        if (n_in != 13 || in_sizes[0] != S * DM || out_size != S * DM || ws_size < WS_END) { fprintf(stderr, "kernel_launch: unexpected shapes (n_in %d, in0 %d, out %d, ws %zu)\n", n_in, n_in > 0 ? in_sizes[0] : -1, out_size, ws_size); grid = -1; return; }
        int dev = 0, cus = 0, per_cu = 0;
        if (hipGetDevice(&dev) != hipSuccess || hipDeviceGetAttribute(&cus, hipDeviceAttributeMultiprocessorCount, dev) != hipSuccess) { grid = -1; return; }
        if (hipFuncSetAttribute((const void*)hymba_fwd, hipFuncAttributeMaxDynamicSharedMemorySize, LDS_BYTES) != hipSuccess) { fprintf(stderr, "kernel_launch: hipFuncSetAttribute failed\n"); grid = -1; return; }
        if (hipOccupancyMaxActiveBlocksPerMultiprocessor(&per_cu, (const void*)hymba_fwd, NTHREADS, LDS_BYTES) != hipSuccess || per_cu < 1) { fprintf(stderr, "kernel_launch: occupancy query gave %d\n", per_cu); per_cu = 1; }
        (void)hipGetLastError();
        grid = cus * per_cu;
    }
    if (grid < 0) return;
    Args a{};
    for (int i = 0; i < 13; ++i) a.in[i] = (const float*)d_in[i];
    a.out = (float*)d_out; a.ws = (unsigned char*)d_ws;
    void* kargs[] = {&a};
    hipError_t e = hipLaunchCooperativeKernel((const void*)hymba_fwd, dim3(grid), dim3(NTHREADS), kargs, LDS_BYTES, stream);
    if (e != hipSuccess) fprintf(stderr, "cooperative launch failed: %s (grid %d)\n", hipGetErrorString(e), grid);
}
```

```cpp
#include <hip/hip_runtime.h>
#include <hip/hip_cooperative_groups.h>
#include <cstdio>
#include <cstdint>
#include <cmath>
namespace pg8 {
#define PG8_LAS __attribute__((address_space(3)))
typedef unsigned short bf16_t;
typedef short bf16x8 __attribute__((ext_vector_type(8)));
typedef float f32x4 __attribute__((ext_vector_type(4)));
typedef unsigned u32x4 __attribute__((ext_vector_type(4)));
constexpr int BM = 256, BK = 64, HALF = 128, HTB = HALF * BK * 2  , STAGE_BYTES = 8 * HTB, NXCD = 8, WGM = 8;

__host__ __device__ __forceinline__ int lds_byte(int r, int c) { const int st = (r >> 4) * 2 + (c >> 5), rr = r & 15, cc = c & 31, ob = rr * 64 + cc * 2; return st * 1024 + (ob ^ (((ob >> 9) & 1) << 5)); }
__host__ __device__ __forceinline__ void stage_rc(int b, int& R, int& C) { const int st = b / 1024, sb = b % 1024, swz = sb ^ (((sb >> 9) & 1) << 5); R = (st >> 1) * 16 + swz / 64; C = (st & 1) * 32 + (swz % 64) / 2; }
__host__ __device__ __forceinline__ int perm32(int rho) { const int n = rho >> 4, i = rho & 15; return 8 * (i >> 2) + 4 * n + (i & 3); }

struct Unit { int pm, pn; };
struct Gemm { const bf16_t* A; const bf16_t* Bt; int M, N, K; };

struct StaticOrder {
    int nM, nN, nwg, G, c;
    __host__ __device__ void init(int M, int N, int G_, int c_) { nM = M / BM; nN = N / BM; nwg = nM * nN; G = G_; c = c_; }
    __host__ __device__ bool next(int i, Unit& u) const {
        const long L = (long)i * G + c; if (L >= nwg) return false;
        int wgid = (int)L; { const int q = nwg / NXCD, r = nwg % NXCD, xcd = wgid % NXCD, off = wgid / NXCD; wgid = (xcd < r ? xcd * (q + 1) : r * (q + 1) + (xcd - r) * q) + off; }
        const int nig = WGM * nN, gid = wgid / nig, fm = gid * WGM, gsz = (nM - fm) < WGM ? (nM - fm) : WGM;
        u.pm = fm + ((wgid % nig) % gsz); u.pn = (wgid % nig) / gsz; return true;
    }
    __device__ __forceinline__ void a_ready(const Unit&) const {}
    __device__ __forceinline__ void done(const Unit&) const {}
};

__device__ __forceinline__ unsigned cvt_pk_bf16(float lo, float hi) { unsigned r; asm volatile("v_cvt_pk_bf16_f32 %0, %1, %2" : "=v"(r) : "v"(lo), "v"(hi)); return r; }
struct EpiProj {
    static constexpr bool PERM = true, AFTER_DRAIN = false, HAS_MID = false;
    bf16_t* O; int ldc; const float* bias; const float *cosA, *sinA, *cosB, *sinB;
    __device__ __forceinline__ void mid(f32x4 (&)[2][2][4][2], const Unit&, int, int) const {}
    __device__ __forceinline__ void operator()(const f32x4 (&acc)[2][2][4][2], const Unit& u, int wr, int wc, int fr, int fq) const {
        typedef unsigned u32x2 __attribute__((ext_vector_type(2)));
        const int row0 = u.pm * BM + wr * 64 + fr;
#pragma unroll
        for (int bj = 0; bj < 2; ++bj) {
            const int colt = u.pn * BM + bj * HALF; int l0, l1, tst = 0, toff = 0; const float *ct = nullptr, *st = nullptr;
            if (colt < 2048) { const int jj = 4 * wc + fq; l0 = colt + 4 * jj; l1 = l0 + 64; ct = cosA; st = sinA; tst = 64; toff = 4 * jj; }
            else if (colt >= 3072 && colt < 4224) { const int jj = 4 * (wc & 1) + fq; l0 = colt + (wc >> 1) * 64 + 4 * jj; l1 = l0 + 32; ct = cosB; st = sinB; tst = 32; toff = 4 * jj; }
            else { l0 = colt + wc * 32 + 8 * fq; l1 = l0 + 4; }
            const f32x4 b0 = *(const f32x4*)(bias + l0), b1 = *(const f32x4*)(bias + l1);
#pragma unroll
            for (int ai = 0; ai < 2; ++ai)
#pragma unroll
                for (int m = 0; m < 4; ++m) { const int row = row0 + ai * HALF + m * 16; const f32x4 v0 = acc[ai][bj][m][0] + b0, v1 = acc[ai][bj][m][1] + b1; f32x4 o0 = v0, o1 = v1;
                    if (ct) { const f32x4 cv = *(const f32x4*)(ct + (size_t)row * tst + toff), sv = *(const f32x4*)(st + (size_t)row * tst + toff); o0 = v0 * cv - v1 * sv; o1 = v1 * cv + v0 * sv; }
                    bf16_t* rowp = O + (size_t)row * ldc; u32x2 w0, w1; w0.x = cvt_pk_bf16(o0[0], o0[1]); w0.y = cvt_pk_bf16(o0[2], o0[3]); w1.x = cvt_pk_bf16(o1[0], o1[1]); w1.y = cvt_pk_bf16(o1[2], o1[3]);
                    *(u32x2*)(rowp + l0) = w0; *(u32x2*)(rowp + l1) = w1; }
        }
    }
};
struct EpiRes {
    static constexpr bool PERM = false, AFTER_DRAIN = false, HAS_MID = false;
    __device__ __forceinline__ void mid(f32x4 (&)[2][2][4][2], const Unit&, int, int) const {}
    const float* base; float* out; int ldc; float alpha;
    __device__ __forceinline__ void operator()(const f32x4 (&acc)[2][2][4][2], const Unit& u, int wr, int wc, int fr, int fq) const {
        const int col0 = u.pn * BM + wc * 32 + 4 * fq;
#pragma unroll
        for (int ai = 0; ai < 2; ++ai)
#pragma unroll
            for (int m = 0; m < 4; ++m) { const size_t off = (size_t)(u.pm * BM + ai * HALF + wr * 64 + m * 16 + fr) * ldc + col0;
#pragma unroll
                for (int bj = 0; bj < 2; ++bj)
#pragma unroll
                    for (int n = 0; n < 2; ++n) { const f32x4 bs = *(const f32x4*)(base + off + bj * HALF + n * 16);
                        *(f32x4*)(out + off + bj * HALF + n * 16) = bs * alpha + acc[ai][bj][m][n]; } }
    }
};
struct EpiResRms {
    static constexpr bool PERM = false, AFTER_DRAIN = false, HAS_MID = true;
    const float* base; float* out; int ldc; float alpha; const float* ssq; int mid_t; float inv_n, eps;
    __device__ __forceinline__ void mid(f32x4 (&acc)[2][2][4][2], const Unit& u, int wr, int fr) const {
#pragma unroll
        for (int ai = 0; ai < 2; ++ai)
#pragma unroll
            for (int m = 0; m < 4; ++m) { const int row = u.pm * BM + ai * HALF + wr * 64 + m * 16 + fr; const float sa = ssq[2 * row], sb = ssq[2 * row + 1];
                const float ratio = __builtin_amdgcn_sqrtf((sb * inv_n + eps) * __builtin_amdgcn_rcpf(sa * inv_n + eps));
                asm volatile("" ::: "memory");
#pragma unroll
                for (int bj = 0; bj < 2; ++bj)
#pragma unroll
                    for (int n = 0; n < 2; ++n) acc[ai][bj][m][n] = acc[ai][bj][m][n] * ratio; }
    }
    __device__ __forceinline__ void operator()(const f32x4 (&acc)[2][2][4][2], const Unit& u, int wr, int wc, int fr, int fq) const {
        const int col0 = u.pn * BM + wc * 32 + 4 * fq;
#pragma unroll
        for (int ai = 0; ai < 2; ++ai)
#pragma unroll
            for (int m = 0; m < 4; ++m) { const int row = u.pm * BM + ai * HALF + wr * 64 + m * 16 + fr; const size_t off = (size_t)row * ldc + col0;
                const float rb = __builtin_amdgcn_rsqf(ssq[2 * row + 1] * inv_n + eps);
#pragma unroll
                for (int bj = 0; bj < 2; ++bj)
#pragma unroll
                    for (int n = 0; n < 2; ++n) { const f32x4 bs = *(const f32x4*)(base + off + bj * HALF + n * 16);
                        *(f32x4*)(out + off + bj * HALF + n * 16) = bs * alpha + acc[ai][bj][m][n] * rb; } }
    }
};
struct EpiSwiglu {
    static constexpr bool PERM = true, AFTER_DRAIN = false, HAS_MID = false;
    __device__ __forceinline__ void mid(f32x4 (&)[2][2][4][2], const Unit&, int, int) const {}
    bf16_t* O; int ldc;
    __device__ __forceinline__ void operator()(const f32x4 (&acc)[2][2][4][2], const Unit& u, int wr, int wc, int fr, int fq) const {
        const int row0 = u.pm * BM + wr * 64 + fr; const int col0 = u.pn * HALF + wc * 32 + 8 * fq;
#pragma unroll
        for (int ai = 0; ai < 2; ++ai)
#pragma unroll
            for (int m = 0; m < 4; ++m) { bf16_t* rowp = O + (size_t)(row0 + ai * HALF + m * 16) * ldc + col0;
                float hv[8];
#pragma unroll
                for (int n = 0; n < 2; ++n)
#pragma unroll
                    for (int i = 0; i < 4; ++i) { const float gt = acc[ai][0][m][n][i], up = acc[ai][1][m][n][i];
                        const float sg = __builtin_amdgcn_rcpf(1.0f + __builtin_amdgcn_exp2f(-1.44269504089f * gt));
                        hv[n * 4 + i] = gt * sg * up; }
                u32x4 w; w.x = cvt_pk_bf16(hv[0], hv[1]); w.y = cvt_pk_bf16(hv[2], hv[3]); w.z = cvt_pk_bf16(hv[4], hv[5]); w.w = cvt_pk_bf16(hv[6], hv[7]);
                *(u32x4*)rowp = w; }
    }
};

template <class Epi, class Sched, bool ALIGN_EPI = false, bool SP2 = false>
__device__ __forceinline__ void gemm_phase(PG8_LAS unsigned char* lds, const Gemm g, const Sched& S, const Epi& E) {
    int tid_ = threadIdx.x; asm volatile("" : "+v"(tid_));
    const int tid = tid_, wid = __builtin_amdgcn_readfirstlane(tid >> 6), lane = tid & 63, wr = wid >> 2, wc = wid & 3, fr = lane & 15, fq = lane >> 4;
    const int K = g.K, nt = K / BK;
    unsigned voffA[2], voffB[2];
#pragma unroll
    for (int i = 0; i < 2; ++i) { int R, C; stage_rc(tid * 16 + i * 8192, R, C); const int Rb = Epi::PERM ? ((R & ~31) + perm32(R & 31)) : R;
        voffA[i] = (unsigned)(R * K + C) * 2u; voffB[i] = (unsigned)(Rb * K + C) * 2u; }
    const size_t kstep = (size_t)(BK * 2);
    const size_t hstep = (size_t)HALF * K * 2;
    const size_t tstep = 2 * hstep;
    const unsigned ldsw = (unsigned)wid * 1024u;
    const int aoff = lds_byte(wr * 64 + fr, fq * 8), boff = lds_byte(wc * 32 + fr, fq * 8);
#define PG8_SA(b, h) (((b) * 2 + (h)) * HTB)
#define PG8_SB(b, h) ((4 + (b) * 2 + (h)) * HTB)
#define PG8_STAGE(bufoff, gbase, voff) do { _Pragma("unroll") for (int _i = 0; _i < 2; ++_i) \
        __builtin_amdgcn_global_load_lds((const unsigned*)((const char*)(gbase) + (voff)[_i]), (PG8_LAS unsigned*)(lds + (bufoff) + ldsw + _i * 8192), 16, 0, 0); } while (0)
#define PG8_LDA(dst, b, h) do { _Pragma("unroll") for (int m = 0; m < 4; ++m) _Pragma("unroll") for (int k = 0; k < 2; ++k) dst[m][k] = *(const PG8_LAS bf16x8*)(lds + PG8_SA(b, h) + aoff + m * 2048 + k * 1024); } while (0)
#define PG8_LDB(dst, b, h) do { _Pragma("unroll") for (int n = 0; n < 2; ++n) _Pragma("unroll") for (int k = 0; k < 2; ++k) dst[n][k] = *(const PG8_LAS bf16x8*)(lds + PG8_SB(b, h) + boff + n * 2048 + k * 1024); } while (0)
#define PG8_MMA(ai, bj, At, Bt) do { __builtin_amdgcn_s_setprio(1); _Pragma("unroll") for (int m = 0; m < 4; ++m) _Pragma("unroll") for (int n = 0; n < 2; ++n) _Pragma("unroll") for (int k = 0; k < 2; ++k) \
        acc[ai][bj][m][n] = __builtin_amdgcn_mfma_f32_16x16x32_bf16(Bt[n][k], At[m][k], acc[ai][bj][m][n], 0, 0, 0); __builtin_amdgcn_s_setprio(0); } while (0)
#define PG8_WAIT_V(n) asm volatile("s_waitcnt vmcnt(" #n ")" ::: "memory")
#define PG8_WAIT_L(n) asm volatile("s_waitcnt lgkmcnt(" #n ")" ::: "memory")
#define PG8_BAR __builtin_amdgcn_s_barrier()
#define PG8_SCHED __builtin_amdgcn_sched_barrier(0)
    Unit cur, nxt; int ui = 0;
    if (!S.next(0, cur)) return;
    f32x4 acc[2][2][4][2];
#pragma unroll
    for (int a = 0; a < 2; ++a)
#pragma unroll
        for (int b = 0; b < 2; ++b)
#pragma unroll
            for (int m = 0; m < 4; ++m)
#pragma unroll
                for (int n = 0; n < 2; ++n) acc[a][b][m][n] = (f32x4){0.f, 0.f, 0.f, 0.f};
    bf16x8 At[4][2], B0[2][2], B1[2][2];
    const char* cA = (const char*)g.A + (size_t)cur.pm * tstep; const char* cB = (const char*)g.Bt + (size_t)cur.pn * tstep;
    S.a_ready(cur);
    if constexpr (SP2) {
        PG8_STAGE(PG8_SB(0, 0), cB, voffB); PG8_STAGE(PG8_SB(0, 1), cB + hstep, voffB); PG8_STAGE(PG8_SA(0, 0), cA, voffA); PG8_STAGE(PG8_SA(0, 1), cA + hstep, voffA);
        if (wr == 1) PG8_BAR;
        PG8_WAIT_V(2); PG8_BAR;
        PG8_STAGE(PG8_SB(1, 0), cB + kstep, voffB); PG8_STAGE(PG8_SA(1, 0), cA + kstep, voffA); PG8_STAGE(PG8_SB(1, 1), cB + hstep + kstep, voffB);
        PG8_WAIT_V(6); PG8_BAR;
    } else {
        PG8_STAGE(PG8_SB(0, 0), cB, voffB); PG8_STAGE(PG8_SA(0, 0), cA, voffA); PG8_STAGE(PG8_SB(0, 1), cB + hstep, voffB); PG8_STAGE(PG8_SA(0, 1), cA + hstep, voffA);
        if (wr == 1) PG8_BAR;
        PG8_WAIT_V(4); PG8_BAR;
        PG8_STAGE(PG8_SB(1, 0), cB + kstep, voffB); PG8_STAGE(PG8_SA(1, 0), cA + kstep, voffA); PG8_STAGE(PG8_SB(1, 1), cB + hstep + kstep, voffB);
        PG8_WAIT_V(6); PG8_BAR;
    }
    for (;;) {
        const bool has_next = S.next(ui + 1, nxt);
        const char* nA = has_next ? (const char*)g.A + (size_t)nxt.pm * tstep : cA; const char* nB = has_next ? (const char*)g.Bt + (size_t)nxt.pn * tstep : cB;
        for (int t = 0; t < nt; t += 2) {
            const bool last = (t == nt - 2);
            const char* a1 = cA + (size_t)(t + 1) * kstep;
            const char* a2 = last ? nA : cA + (size_t)(t + 2) * kstep; const char* b2 = last ? nB : cB + (size_t)(t + 2) * kstep;
            const char* a3 = a2 + kstep; const char* b3 = b2 + kstep;
            if (last && has_next) S.a_ready(nxt);
            if constexpr (Epi::HAS_MID) { if (t == E.mid_t) E.mid(acc, cur, wr, fr); }
            if constexpr (SP2) {
            PG8_LDB(B0, 0, 0); PG8_LDB(B1, 0, 1); PG8_SCHED; PG8_LDA(At, 0, 0); PG8_STAGE(PG8_SA(1, 1), a1 + hstep, voffA);
            PG8_WAIT_V(8); PG8_WAIT_L(0); PG8_BAR; PG8_MMA(0, 0, At, B0); PG8_MMA(0, 1, At, B1); PG8_BAR; PG8_SCHED;
            PG8_LDA(At, 0, 1); PG8_STAGE(PG8_SB(0, 0), b2, voffB); PG8_STAGE(PG8_SB(0, 1), b2 + hstep, voffB); PG8_STAGE(PG8_SA(0, 0), a2, voffA);
            PG8_WAIT_V(8); PG8_WAIT_L(0); PG8_BAR; PG8_MMA(1, 0, At, B0); PG8_MMA(1, 1, At, B1); PG8_BAR; PG8_SCHED;
            PG8_LDB(B0, 1, 0); PG8_LDB(B1, 1, 1); PG8_SCHED; PG8_LDA(At, 1, 0); PG8_STAGE(PG8_SA(0, 1), a2 + hstep, voffA);
            PG8_WAIT_V(8); PG8_WAIT_L(0); PG8_BAR; PG8_MMA(0, 0, At, B0); PG8_MMA(0, 1, At, B1); PG8_BAR; PG8_SCHED;
            PG8_LDA(At, 1, 1); PG8_STAGE(PG8_SB(1, 0), b3, voffB); PG8_STAGE(PG8_SB(1, 1), b3 + hstep, voffB); PG8_STAGE(PG8_SA(1, 0), a3, voffA);
            PG8_WAIT_V(8); PG8_WAIT_L(0); PG8_BAR; PG8_MMA(1, 0, At, B0); PG8_MMA(1, 1, At, B1); PG8_BAR; PG8_SCHED;
            } else {
            PG8_LDB(B0, 0, 0); PG8_SCHED; PG8_LDA(At, 0, 0); PG8_STAGE(PG8_SA(1, 1), a1 + hstep, voffA);
            PG8_WAIT_L(8); PG8_BAR; PG8_WAIT_L(0); PG8_MMA(0, 0, At, B0); PG8_BAR; PG8_SCHED;
            PG8_LDB(B1, 0, 1); PG8_STAGE(PG8_SB(0, 0), b2, voffB);
            PG8_BAR; PG8_WAIT_L(0); PG8_MMA(0, 1, At, B1); PG8_BAR;
            PG8_LDA(At, 0, 1); PG8_STAGE(PG8_SA(0, 0), a2, voffA);
            PG8_BAR; PG8_WAIT_L(0); PG8_MMA(1, 0, At, B0); PG8_BAR; PG8_SCHED;
            PG8_STAGE(PG8_SB(0, 1), b2 + hstep, voffB);
            PG8_WAIT_V(6); PG8_BAR; PG8_MMA(1, 1, At, B1); PG8_BAR;
            PG8_LDB(B0, 1, 0); PG8_SCHED; PG8_LDA(At, 1, 0); PG8_STAGE(PG8_SA(0, 1), a2 + hstep, voffA);
            PG8_WAIT_L(8); PG8_BAR; PG8_WAIT_L(0); PG8_MMA(0, 0, At, B0); PG8_BAR; PG8_SCHED;
            PG8_LDB(B1, 1, 1); PG8_STAGE(PG8_SB(1, 0), b3, voffB);
            PG8_BAR; PG8_WAIT_L(0); PG8_MMA(0, 1, At, B1); PG8_BAR;
            PG8_LDA(At, 1, 1); PG8_STAGE(PG8_SA(1, 0), a3, voffA);
            PG8_BAR; PG8_WAIT_L(0); PG8_MMA(1, 0, At, B0); PG8_BAR; PG8_SCHED;
            PG8_STAGE(PG8_SB(1, 1), b3 + hstep, voffB);
            PG8_WAIT_V(6); PG8_BAR; PG8_MMA(1, 1, At, B1); PG8_BAR;
            }
        }
        if constexpr (ALIGN_EPI) { if (wr == 0) PG8_BAR; }
        if constexpr (!Epi::AFTER_DRAIN) { E(acc, cur, wr, wc, fr, fq); S.done(cur); }
        if (!has_next) break;
#pragma unroll
        for (int a = 0; a < 2; ++a)
#pragma unroll
            for (int b = 0; b < 2; ++b)
#pragma unroll
                for (int m = 0; m < 4; ++m)
#pragma unroll
                    for (int n = 0; n < 2; ++n) acc[a][b][m][n] = (f32x4){0.f, 0.f, 0.f, 0.f};
        cur = nxt; cA = nA; cB = nB; ++ui;
        if constexpr (ALIGN_EPI) { if (wr == 1) PG8_BAR; }
    }
    PG8_WAIT_V(0);
    if constexpr (!ALIGN_EPI) { if (wr == 0) PG8_BAR; }
    PG8_BAR;
    if constexpr (Epi::AFTER_DRAIN) { E.fused(acc, cur, wr, wc, fr, fq, lds, wid, lane); S.done(cur); }
#undef PG8_SA
#undef PG8_SB
#undef PG8_STAGE
#undef PG8_LDA
#undef PG8_LDB
#undef PG8_MMA
#undef PG8_WAIT_V
#undef PG8_WAIT_L
#undef PG8_BAR
#undef PG8_SCHED
}
}

namespace cg = cooperative_groups;
#define GAS __attribute__((address_space(1)))
#define LAS __attribute__((address_space(3)))
typedef unsigned short bf16;
typedef unsigned v4u __attribute__((ext_vector_type(4)));
typedef unsigned v2u __attribute__((ext_vector_type(2)));
typedef float f32x4 __attribute__((ext_vector_type(4)));
typedef short bf16x8 __attribute__((ext_vector_type(8)));
typedef short s16x4 __attribute__((ext_vector_type(4)));

constexpr int NWAVES = 8, NTHREADS = NWAVES * 64;
constexpr int S = 16384, DM = 2048, INW = 4352, DFF = 5632, NUP = 2 * DFF;
constexpr int QA_OFF = 0, KA_OFF = 1024, VA_OFF = 2048, QB_OFF = 3072, KB_OFF = 4096, VB_OFF = 4224;
constexpr float ALPHA = 1.189207115002721f;
constexpr float LN_EPS = 1e-5f, RMS_EPS = 1e-6f;
constexpr int LDS_BYTES = 147456;

constexpr size_t MiB = 1u << 20;
constexpr size_t WS_SSQ = 0;
constexpr size_t WS_BAR = 512 * 1024;
constexpr size_t WS_COSA = 1 * MiB, WS_SINA = 5 * MiB, WS_COSB = 9 * MiB, WS_SINB = 11 * MiB;
constexpr size_t WS_WI = 16 * MiB, WS_WO = 33 * MiB, WS_WU = 41 * MiB, WS_WD = 85 * MiB;
constexpr size_t WS_XB = 108 * MiB;
constexpr size_t WS_PROJ = 172 * MiB;
constexpr size_t WS_Y = 308 * MiB;
constexpr size_t WS_H = 172 * MiB;
constexpr size_t WS_END = 372 * MiB;
static_assert(WS_WI + (size_t)INW * DM * 2 <= WS_WO && WS_WO + (size_t)DM * DM * 2 <= WS_WU && WS_WU + (size_t)NUP * DM * 2 <= WS_WD && WS_WD + (size_t)DM * DFF * 2 <= WS_XB, "ws map (weights)");
static_assert(WS_XB + (size_t)S * DM * 2 <= WS_PROJ && WS_PROJ + (size_t)S * INW * 2 <= WS_Y && WS_Y + (size_t)S * DM * 2 <= WS_END && WS_H + (size_t)S * DFF * 2 <= WS_END, "ws map (activations)");

__device__ __forceinline__ unsigned f2bf(float f) { unsigned u = __builtin_bit_cast(unsigned, f); return (u + 0x7fffu + ((u >> 16) & 1u)) >> 16; }
__device__ __forceinline__ unsigned pk2(float lo, float hi) { return f2bf(lo) | (f2bf(hi) << 16); }
__device__ __forceinline__ float bflo(unsigned w) { return __builtin_bit_cast(float, w << 16); }
__device__ __forceinline__ float bfhi(unsigned w) { return __builtin_bit_cast(float, w & 0xffff0000u); }
#define LDS_WAIT() asm volatile("s_waitcnt lgkmcnt(0)" ::: "memory")

__device__ __forceinline__ float wave_sum(float v) {
#pragma unroll
    for (int o = 1; o < 64; o <<= 1) v += __shfl_xor(v, o);
    return v;
}

__device__ __forceinline__ void p0_transpose_item(const float* W, int K, int N, bf16* WT, int k0, int n0, int drow0, bool perm, const float* gk, LAS float* scr, int lane) {
#pragma unroll 8
    for (int i = 0; i < 32; ++i) { const int kk = 2 * i + (lane >> 5); float w = W[(size_t)(k0 + kk) * N + n0 + (lane & 31)]; if (gk) w *= gk[k0 + kk]; scr[kk * 33 + (lane & 31)] = w; }
    LDS_WAIT(); asm volatile("" ::: "memory");
    const int c = lane & 7;
#pragma unroll
    for (int j = 0; j < 4; ++j) { const int n = (lane >> 3) + 8 * j; const LAS float* s = scr + (8 * c) * 33 + n; const int dr = drow0 + (perm ? 8 * (n >> 2) + (n & 3) : n);
        v4u o; o.x = pk2(s[0 * 33], s[1 * 33]); o.y = pk2(s[2 * 33], s[3 * 33]); o.z = pk2(s[4 * 33], s[5 * 33]); o.w = pk2(s[6 * 33], s[7 * 33]);
        *(v4u*)(WT + (size_t)dr * K + k0 + 8 * c) = o; }
    LDS_WAIT(); asm volatile("" ::: "memory");
}

#define RLX_AGENT __ATOMIC_RELAXED, __HIP_MEMORY_SCOPE_AGENT
#define XB_TMO      128
#define XB_XCNT(j)  (256  + 64 * (j))
#define XB_XSUB(j)  (1280 + 64 * (j))
#define XB_XGEN(j)  (2304 + 64 * (j))
#define XB_TOP      3328
#define XB_TOPGEN   3392
#define XCD_BAR_WORDS 3456
#define XB_SPIN_CAP (1u << 18)

__device__ __forceinline__ unsigned xb_ld(unsigned* p)              { return __hip_atomic_load(p, __ATOMIC_RELAXED, __HIP_MEMORY_SCOPE_AGENT); }
__device__ __forceinline__ unsigned xb_add(unsigned* p, unsigned v) { return __hip_atomic_fetch_add(p, v, __ATOMIC_RELAXED, __HIP_MEMORY_SCOPE_AGENT); }
__device__ __forceinline__ unsigned xb_xcc_id() { return (unsigned)__builtin_amdgcn_s_getreg((3 << 11) | 20) & 0xFu; }
#define XB_SPIN(cond, bar) do { unsigned _sp = 0; while (cond) { __builtin_amdgcn_s_sleep(1); \
    if ((++_sp & 255u) == 0u) { if (xb_ld(&(bar)[XB_TMO])) break; if (_sp > XB_SPIN_CAP) { atomicAdd(&(bar)[XB_TMO], 1u); break; } } } } while (0)

struct XcdBarrier {
    unsigned* bar; unsigned x;
    volatile LAS unsigned* st;
};

__device__ __forceinline__ XcdBarrier xcd_barrier_post(unsigned* bar, volatile LAS unsigned* st) {
    XcdBarrier b; b.bar = bar; b.x = xb_xcc_id(); b.st = st;
    if (threadIdx.x == 0) (void)xb_add(&bar[XB_XCNT(b.x)], 1u);
    return b;
}
__device__ __forceinline__ void xcd_barrier_complete(unsigned* bar, unsigned x, unsigned& nloc, unsigned& nx) {
    const unsigned G = gridDim.x * gridDim.y * gridDim.z;
    unsigned sum, cnt, mine, sp = 0u;
    for (;;) {
        sum = 0u; cnt = 0u; mine = 0u;
#pragma unroll
        for (unsigned j = 0; j < 16; ++j) { const unsigned c = xb_ld(&bar[XB_XCNT(j)]); sum += c; cnt += (c > 0u) ? 1u : 0u; mine = (j == x) ? c : mine; }
        if (sum == G) break;
        __builtin_amdgcn_s_sleep(1);
        if ((++sp & 255u) == 0u) { if (xb_ld(&bar[XB_TMO])) break; if (sp > XB_SPIN_CAP) { atomicAdd(&bar[XB_TMO], 1u); break; } }
    }
    nloc = mine > 0u ? mine : 1u; nx = cnt > 0u ? cnt : 1u;
}

__device__ __forceinline__ void xcd_barrier(const XcdBarrier& b) {
    asm volatile("s_waitcnt vmcnt(0)" ::: "memory");
    __syncthreads();
    if (threadIdx.x == 0) {
        unsigned* bar = b.bar;
        __builtin_amdgcn_s_waitcnt(0);
        unsigned nloc = b.st[0], nx = b.st[1];
        if (nloc == 0u) { xcd_barrier_complete(bar, b.x, nloc, nx); b.st[0] = nloc; b.st[1] = nx; }
        const unsigned old = xb_add(&bar[XB_XSUB(b.x)], 1u);
        const unsigned gen = old / nloc;
        if (old + 1u == (gen + 1u) * nloc) {
            __builtin_amdgcn_fence(__ATOMIC_RELEASE, "agent");
            asm volatile("s_waitcnt vmcnt(0)" ::: "memory");
            const unsigned og = xb_add(&bar[XB_TOP], 1u);
            const unsigned tg = og / nx;
            if (og + 1u == (tg + 1u) * nx) xb_add(&bar[XB_TOPGEN], 1u);
            else XB_SPIN(xb_ld(&bar[XB_TOPGEN]) == tg, bar);
            __builtin_amdgcn_fence(__ATOMIC_ACQUIRE, "agent");
            xb_add(&bar[XB_XGEN(b.x)], 1u);
            asm volatile("s_waitcnt vmcnt(0)" ::: "memory");
        } else {
            XB_SPIN(xb_ld(&bar[XB_XGEN(b.x)]) == gen, bar);
            __builtin_amdgcn_fence(__ATOMIC_ACQUIRE, "agent");
            asm volatile("s_waitcnt vmcnt(0)" ::: "memory");
        }
    }
    __syncthreads();
}

struct Args { const float* in[13]; float* out; unsigned char* ws; };

__device__ __forceinline__ void phase_prologue(const Args& a, LAS unsigned char* lds, int gw, int NGW, int lane, int wave) {
    unsigned char* ws = a.ws;
    LAS float* scr = (LAS float*)(lds + wave * 16384);
    const float* w_in = a.in[1]; const float* w_out = a.in[6]; const float* w_up = a.in[9]; const float* w_down = a.in[10];
    bf16* Wi = (bf16*)(ws + WS_WI); bf16* Wo = (bf16*)(ws + WS_WO); bf16* Wu = (bf16*)(ws + WS_WU); bf16* Wd = (bf16*)(ws + WS_WD);
    constexpr int I_IN = (DM / 64) * (INW / 32), I_OUT = (DM / 64) * (DM / 32), I_UP = (DM / 64) * (NUP / 32), I_DN = (DFF / 64) * (DM / 32);
    constexpr int NITEMS = I_IN + I_OUT + I_UP + I_DN;
    for (int it = gw; it < NITEMS; it += NGW) {
        int r = it;
        if (r < I_IN) { const int nb = INW / 32, kb = r / nb, n0 = (r % nb) * 32; int dr = n0; bool pm = false;
            if (n0 < 2048) { const int d0 = n0 & 127; dr = (n0 & ~127) + 2 * (d0 & 63) + 4 * (d0 >> 6); pm = true; }
            else if (n0 >= QB_OFF && n0 < VB_OFF) { const int d0 = n0 & 63; dr = (n0 & ~63) + 4 * (d0 >> 5); pm = true; }
            p0_transpose_item(w_in, DM, INW, Wi, kb * 64, n0, dr, pm, nullptr, scr, lane); continue; } r -= I_IN;
        if (r < I_OUT) { const int nb = DM / 32, kb = r / nb, n0 = (r % nb) * 32; p0_transpose_item(w_out, DM, DM, Wo, kb * 64, n0, n0, false, (kb * 64 < 1024) ? a.in[4] : a.in[5] - 1024, scr, lane); continue; } r -= I_OUT;
        if (r < I_UP) { const int nb = NUP / 32, kb = r / nb, n0 = (r % nb) * 32; const int half = n0 / DFF, rem = n0 % DFF;
            p0_transpose_item(w_up, DM, NUP, Wu, kb * 64, n0, 256 * (rem / 128) + 128 * half + (rem % 128), false, nullptr, scr, lane); continue; } r -= I_UP;
        { const int nb = DM / 32, kb = r / nb, n0 = (r % nb) * 32; p0_transpose_item(w_down, DFF, DM, Wd, kb * 64, n0, n0, false, nullptr, scr, lane); }
    }
    const int gt = gw * 64 + lane, NGT = NGW * 64;
    { const f32x4* x4 = (const f32x4*)a.in[0]; v4u* xb = (v4u*)(ws + WS_XB);
      for (int i = gt; i < S * DM / 8; i += NGT) { const f32x4 p = x4[2 * i], q = x4[2 * i + 1]; v4u o; o.x = pk2(p[0], p[1]); o.y = pk2(p[2], p[3]); o.z = pk2(q[0], q[1]); o.w = pk2(q[2], q[3]); xb[i] = o; } }
    { float* cA = (float*)(ws + WS_COSA); float* sA = (float*)(ws + WS_SINA); float* cB = (float*)(ws + WS_COSB); float* sB = (float*)(ws + WS_SINB);
      for (int i = gt; i < S * 96; i += NGT) { const int pos = i / 96, j = i % 96; const bool isA = j < 64; const int jj = isA ? j : j - 64;
          const double e = -(double)jj * (isA ? (13.287712379549449 / 64.0) : (13.287712379549449 / 32.0));
          const double inv = exp2(e); double turns = (double)pos * inv * 0.15915494309189535; turns -= floor(turns);
          const float fr = (float)turns; const float cv = __builtin_amdgcn_cosf(fr), sv = __builtin_amdgcn_sinf(fr);
          if (isA) { cA[pos * 64 + jj] = cv; sA[pos * 64 + jj] = sv; } else { cB[pos * 32 + jj] = cv; sB[pos * 32 + jj] = sv; } } }
    { float* ssq = (float*)(ws + WS_SSQ); for (int i = gt; i < S * 2; i += NGT) ssq[i] = 0.f; }
}

__device__ __forceinline__ void phase_rope(const Args& a, int gt, int NGT) {
    unsigned char* ws = a.ws; bf16* proj = (bf16*)(ws + WS_PROJ);
    const float* cA = (const float*)(ws + WS_COSA); const float* sA = (const float*)(ws + WS_SINA); const float* cB = (const float*)(ws + WS_COSB); const float* sB = (const float*)(ws + WS_SINB);
    for (int it = gt; it < S * 200; it += NGT) {
        const int pos = it / 200, i = it % 200; int col, pcol; const float *ct, *st;
        if (i < 128) { col = (i >> 3) * 128 + (i & 7) * 8; pcol = col + 64; ct = cA + pos * 64 + (i & 7) * 8; st = sA + pos * 64 + (i & 7) * 8; }
        else { const int j = i - 128; col = QB_OFF + (j >> 2) * 64 + (j & 3) * 8; pcol = col + 32; ct = cB + pos * 32 + (j & 3) * 8; st = sB + pos * 32 + (j & 3) * 8; }
        v4u* p1 = (v4u*)(proj + (size_t)pos * INW + col); v4u* p2 = (v4u*)(proj + (size_t)pos * INW + pcol);
        const v4u u1 = *p1, u2 = *p2; const f32x4 c0 = *(const f32x4*)ct, c1 = *(const f32x4*)(ct + 4), s0 = *(const f32x4*)st, s1 = *(const f32x4*)(st + 4);
        v4u o1, o2;
#pragma unroll
        for (int e = 0; e < 4; ++e) { const float xa = bflo(u1[e]), xb = bfhi(u1[e]), ya = bflo(u2[e]), yb = bfhi(u2[e]);
            const float ca = e < 2 ? c0[2 * e] : c1[2 * e - 4], cb = e < 2 ? c0[2 * e + 1] : c1[2 * e - 3], sa = e < 2 ? s0[2 * e] : s1[2 * e - 4], sb = e < 2 ? s0[2 * e + 1] : s1[2 * e - 3];
            o1[e] = pk2(xa * ca - ya * sa, xb * cb - yb * sb); o2[e] = pk2(ya * ca + xa * sa, yb * cb + xb * sb); }
        *p1 = o1; *p2 = o2;
    }
}

namespace att {
constexpr int VROW = 288, KROW = 272, VBUF = 32 * VROW, KBUF = 32 * KROW, WBUF = VBUF + KBUF;
__device__ __forceinline__ s16x4 vtr(const LAS unsigned char* p) { typedef short v4i16_t __attribute__((ext_vector_type(4)));
    return __builtin_bit_cast(s16x4, __builtin_amdgcn_ds_read_tr16_b64_v4i16((LAS v4i16_t*)p)); }
__device__ __forceinline__ unsigned cvtpk(float lo, float hi) { unsigned r; asm volatile("v_cvt_pk_bf16_f32 %0, %1, %2" : "=v"(r) : "v"(lo), "v"(hi)); return r; }

template <int D> struct KVS { bf16x8 k[D / 16]; bf16x8 v[D / 16]; };

template <int D>
__device__ __forceinline__ void load_kv(KVS<D>& t, const bf16* kcol, const bf16* vcol, int kbase, int dil, int b, int lane) {
    constexpr int CPR = D / 8;
#pragma unroll
    for (int i = 0; i < D / 16; ++i) { const int n = lane + 64 * i, row = n / CPR, ch = n % CPR; int kp = kbase + dil * (32 * b + row); kp = kp < 0 ? 0 : (kp > S - 1 ? S - 1 : kp);
        const size_t ro = (size_t)kp * INW + 8 * ch; t.k[i] = *(const bf16x8*)(kcol + ro); t.v[i] = *(const bf16x8*)(vcol + ro); }
}

template <int D>
__device__ __forceinline__ void span(f32x4 (&o)[D / 16], float& m, float& l, const bf16x8 (&qf)[D / 32], const bf16* kcol, const bf16* vcol,
                                     int kbase, int dil, int nblk, int tqrel, int maxdist, float sc, LAS unsigned char* kl, LAS unsigned char* vl, int lane) {
    const int c = lane & 15, g = lane >> 4, q4 = (lane & 15) >> 2, p4 = lane & 3;
    constexpr int CPR = D / 8;
    KVS<D> st;
    load_kv<D>(st, kcol, vcol, kbase, dil, 0, lane);
    for (int b = 0; b < nblk; ++b) {
#pragma unroll
        for (int i = 0; i < D / 16; ++i) { const int n = lane + 64 * i, row = n / CPR, ch = n % CPR; *(LAS bf16x8*)(kl + row * KROW + ch * 16) = st.k[i]; *(LAS bf16x8*)(vl + row * VROW + ch * 16) = st.v[i]; }
        if (b + 1 < nblk) load_kv<D>(st, kcol, vcol, kbase, dil, b + 1, lane);
        f32x4 a0 = {0.f, 0.f, 0.f, 0.f}, a1 = {0.f, 0.f, 0.f, 0.f};
#pragma unroll
        for (int ks = 0; ks < D / 32; ++ks) { const bf16x8 k0 = *(const LAS bf16x8*)(kl + c * KROW + 64 * ks + 16 * g), k1 = *(const LAS bf16x8*)(kl + (16 + c) * KROW + 64 * ks + 16 * g);
            a0 = __builtin_amdgcn_mfma_f32_16x16x32_bf16(k0, qf[ks], a0, 0, 0, 0); a1 = __builtin_amdgcn_mfma_f32_16x16x32_bf16(k1, qf[ks], a1, 0, 0, 0); }
        float s[8];
#pragma unroll
        for (int e = 0; e < 8; ++e) { const int jj = 32 * b + 16 * (e >> 2) + 4 * g + (e & 3); const int dist = tqrel - dil * jj; const bool ok = ((unsigned)dist <= (unsigned)maxdist) && (kbase + dil * jj >= 0);
            const float v = (e < 4 ? a0[e & 3] : a1[e & 3]) * sc; s[e] = ok ? v : -INFINITY; }
        float ml = fmaxf(fmaxf(fmaxf(s[0], s[1]), fmaxf(s[2], s[3])), fmaxf(fmaxf(s[4], s[5]), fmaxf(s[6], s[7])));
        ml = fmaxf(ml, __shfl_xor(ml, 16)); ml = fmaxf(ml, __shfl_xor(ml, 32));
        const float mn = fmaxf(m, ml); const float ms = (mn == -INFINITY) ? 0.f : mn;
        const float alpha = __builtin_amdgcn_exp2f(m - ms);
        float p[8], ps = 0.f;
#pragma unroll
        for (int e = 0; e < 8; ++e) { p[e] = __builtin_amdgcn_exp2f(s[e] - ms); ps += p[e]; }
        l = l * alpha + ps; m = mn;
#pragma unroll
        for (int nt = 0; nt < D / 16; ++nt) o[nt] = o[nt] * alpha;
        v4u pw; pw.x = cvtpk(p[0], p[1]); pw.y = cvtpk(p[2], p[3]); pw.z = cvtpk(p[4], p[5]); pw.w = cvtpk(p[6], p[7]);
        const bf16x8 pf = __builtin_bit_cast(bf16x8, pw);
#pragma unroll
        for (int nt = 0; nt < D / 16; ++nt) {
            const s16x4 r1 = vtr(vl + (4 * g + q4) * VROW + (16 * nt + 4 * p4) * 2), r2 = vtr(vl + (16 + 4 * g + q4) * VROW + (16 * nt + 4 * p4) * 2);
            bf16x8 vf; vf[0] = r1[0]; vf[1] = r1[1]; vf[2] = r1[2]; vf[3] = r1[3]; vf[4] = r2[0]; vf[5] = r2[1]; vf[6] = r2[2]; vf[7] = r2[3];
            o[nt] = __builtin_amdgcn_mfma_f32_16x16x32_bf16(vf, pf, o[nt], 0, 0, 0);
        }
    }
}

template <int D>
__device__ __forceinline__ void finish(const f32x4 (&o)[D / 16], float ltot, bf16* yrow  , float* ssqp, int lane) {
    const float inv = 1.0f / ltot; float sq = 0.f;
#pragma unroll
    for (int nt = 0; nt < D / 16; ++nt) { const f32x4 v = o[nt] * inv; sq += (v[0] * v[0] + v[1] * v[1]) + (v[2] * v[2] + v[3] * v[3]);
        v2u w; w.x = cvtpk(v[0], v[1]); w.y = cvtpk(v[2], v[3]); *(v2u*)(yrow + 16 * nt) = w; }
    sq += __shfl_xor(sq, 16); sq += __shfl_xor(sq, 32);
    if ((lane >> 4) == 0) atomicAdd(ssqp, sq);
}
}

__device__ __forceinline__ void phase_attention(const Args& a, LAS unsigned char* lds, int gw, int NGW, int lane, int wave) {
    unsigned char* ws = a.ws; const bf16* proj = (const bf16*)(ws + WS_PROJ); bf16* Y = (bf16*)(ws + WS_Y); float* ssq = (float*)(ws + WS_SSQ);
    const float* sinks = a.in[3];
    LAS unsigned char* vl = lds + wave * att::WBUF; LAS unsigned char* kl = vl + att::VBUF;
    const int c = lane & 15, g = lane >> 4;
    const int G_ = NGW / NWAVES; const bool xa = (G_ % 8) == 0; const int wpx = xa ? (G_ / 8) * NWAVES : NGW;
    const int ti0 = xa ? ((int)(blockIdx.x >> 3) * NWAVES + wave) : gw; const int nti = xa ? 1024 : 8 * 1024;
    for (int ti = ti0; ti < nti; ti += wpx) {
        const int t = xa ? (((int)blockIdx.x & 7) << 10) + ti : ti;
        const int r = t & 15, mb = (t >> 4) & 63, h = t >> 10; const int t0 = r + 256 * mb, tq = t0 + 16 * c;
        bf16x8 qf[4];
#pragma unroll
        for (int ks = 0; ks < 4; ++ks) qf[ks] = *(const bf16x8*)(proj + (size_t)tq * INW + QA_OFF + h * 128 + 32 * ks + 8 * g);
        f32x4 o[8];
#pragma unroll
        for (int nt = 0; nt < 8; ++nt) o[nt] = (f32x4){0.f, 0.f, 0.f, 0.f};
        float m = -INFINITY, l = 0.f;
        const bf16* kcol = proj + KA_OFF + h * 128; const bf16* vcol = proj + VA_OFF + h * 128;
        const float sc = 1.44269504089f * 0.08838834764831845f;
        att::span<128>(o, m, l, qf, kcol, vcol, t0 - 128, 1, 12, 16 * c + 128, 128, sc, kl, vl, lane);
        att::span<128>(o, m, l, qf, kcol, vcol, t0 - 512, 4, 6, 16 * c + 512, 512, sc, kl, vl, lane);
        att::span<128>(o, m, l, qf, kcol, vcol, t0 - 2048, 16, 5, 16 * c + 2048, 2048, sc, kl, vl, lane);
        float lt = l; lt += __shfl_xor(lt, 16); lt += __shfl_xor(lt, 32);
        att::finish<128>(o, lt, Y + (size_t)tq * DM + h * 128 + 4 * g, ssq + 2 * tq, lane);
    }
    for (int t = gw; t < 16 * 1024; t += NGW) {
        const int hl = t & 7, pb = (t >> 3) & 1023, kvh = t >> 13, hq = kvh * 8 + hl; const int tq = 16 * pb + c;
        bf16x8 qf[2];
#pragma unroll
        for (int ks = 0; ks < 2; ++ks) qf[ks] = *(const bf16x8*)(proj + (size_t)tq * INW + QB_OFF + hq * 64 + 32 * ks + 8 * g);
        f32x4 o[4];
#pragma unroll
        for (int nt = 0; nt < 4; ++nt) o[nt] = (f32x4){0.f, 0.f, 0.f, 0.f};
        float m = -INFINITY, l = 0.f;
        const bf16* kcol = proj + KB_OFF + kvh * 64; const bf16* vcol = proj + VB_OFF + kvh * 64;
        att::span<64>(o, m, l, qf, kcol, vcol, 16 * pb - 128, 1, 5, c + 128, 127, 1.44269504089f * 0.125f, kl, vl, lane);
        float lt = l; lt += __shfl_xor(lt, 16); lt += __shfl_xor(lt, 32);
        lt += __builtin_amdgcn_exp2f(sinks[hq] * 1.44269504089f - m);
        att::finish<64>(o, lt, Y + (size_t)tq * DM + 1024 + hq * 64 + 4 * g, ssq + 2 * tq + 1, lane);
    }
}

__device__ __forceinline__ void phase_rms(const Args& a, int gt, int NGT) {
    unsigned char* ws = a.ws; v4u* Y = (v4u*)(ws + WS_Y); const float* ssq = (const float*)(ws + WS_SSQ);
    const float* ga = a.in[4]; const float* gb = a.in[5];
    for (int i = gt; i < S * DM / 8; i += NGT) { const int pos = i >> 8, c8 = (i & 255) * 8; const int grp = c8 >> 10;
        const float rs = 1.0f / sqrtf(ssq[2 * pos + grp] * (1.0f / 1024.0f) + RMS_EPS);
        const float* gp = grp ? gb + (c8 - 1024) : ga + c8; const f32x4 g0 = *(const f32x4*)gp, g1 = *(const f32x4*)(gp + 4);
        const v4u u = Y[i]; v4u o;
        o.x = pk2(bflo(u.x) * rs * g0[0], bfhi(u.x) * rs * g0[1]); o.y = pk2(bflo(u.y) * rs * g0[2], bfhi(u.y) * rs * g0[3]);
        o.z = pk2(bflo(u.z) * rs * g1[0], bfhi(u.z) * rs * g1[1]); o.w = pk2(bflo(u.w) * rs * g1[2], bfhi(u.w) * rs * g1[3]);
        Y[i] = o; }
}

__device__ __forceinline__ void phase_ln(float* buf, const float* gam, const float* bet, bf16* xb, int gw, int NGW, int lane) {
    for (int row = gw; row < S; row += NGW) {
        f32x4* xr = (f32x4*)(buf + (size_t)row * DM) + lane;
        f32x4 v[8]; float s = 0.f;
#pragma unroll
        for (int j = 0; j < 8; ++j) { v[j] = xr[64 * j]; s += (v[j][0] + v[j][1]) + (v[j][2] + v[j][3]); }
        const float mean = wave_sum(s) * (1.f / DM); float s2 = 0.f;
#pragma unroll
        for (int j = 0; j < 8; ++j) { v[j] = v[j] - mean; s2 += (v[j][0] * v[j][0] + v[j][1] * v[j][1]) + (v[j][2] * v[j][2] + v[j][3] * v[j][3]); }
        const float rstd = 1.f / sqrtf(wave_sum(s2) * (1.f / DM) + LN_EPS);
#pragma unroll
        for (int j = 0; j < 8; ++j) { const f32x4 gg = *((const f32x4*)gam + lane + 64 * j), bb = *((const f32x4*)bet + lane + 64 * j);
            const f32x4 ov = v[j] * rstd * gg + bb; xr[64 * j] = ov;
            if (xb) { v2u w; w.x = pk2(ov[0], ov[1]); w.y = pk2(ov[2], ov[3]); *((v2u*)(xb + (size_t)row * DM) + lane + 64 * j) = w; } }
    }
}

__global__ void __launch_bounds__(NTHREADS, 2) hymba_fwd(Args args) {
    extern __shared__ __attribute__((aligned(16))) unsigned char lds_raw[];
    LAS unsigned char* lds = (LAS unsigned char*)lds_raw;
    cg::grid_group grid = cg::this_grid();
    const int tid = threadIdx.x, lane = tid & 63, wave = __builtin_amdgcn_readfirstlane(tid >> 6);
    const int G = gridDim.x, gw = blockIdx.x * NWAVES + wave, NGW = G * NWAVES, gt = blockIdx.x * NTHREADS + tid, NGT = G * NTHREADS;
    unsigned char* ws = args.ws;
    bf16* Wi = (bf16*)(ws + WS_WI); bf16* Wo = (bf16*)(ws + WS_WO); bf16* Wu = (bf16*)(ws + WS_WU); bf16* Wd = (bf16*)(ws + WS_WD);
    bf16* XB = (bf16*)(ws + WS_XB); bf16* PROJ = (bf16*)(ws + WS_PROJ); bf16* Y = (bf16*)(ws + WS_Y); bf16* H = (bf16*)(ws + WS_H);

    unsigned* barw = (unsigned*)(ws + WS_BAR);
    if (blockIdx.x == 0) for (int i = tid; i < XCD_BAR_WORDS; i += NTHREADS) __hip_atomic_store(barw + i, 0u, RLX_AGENT);
    volatile LAS unsigned* bst = (volatile LAS unsigned*)(lds + LDS_BYTES - 16);
    if (tid < 4) bst[tid] = 0u;
    phase_prologue(args, lds, gw, NGW, lane, wave);
    grid.sync();
    const XcdBarrier xbar = xcd_barrier_post(barw, bst);
#define SEAM() xcd_barrier(xbar)
    {
        pg8::Gemm g{XB, Wi, S, INW, DM}; pg8::StaticOrder So; So.init(S, INW, G, (int)blockIdx.x);
        pg8::EpiProj E{PROJ, INW, args.in[2], (const float*)(ws + WS_COSA), (const float*)(ws + WS_SINA), (const float*)(ws + WS_COSB), (const float*)(ws + WS_SINB)};
        pg8::gemm_phase<pg8::EpiProj, pg8::StaticOrder, true, true>(lds, g, So, E);
    }
    SEAM();
    phase_attention(args, lds, gw, NGW, lane, wave);
    SEAM();
    {
        pg8::Gemm g{Y, Wo, S, DM, DM}; pg8::StaticOrder So; So.init(S, DM, G, (int)blockIdx.x);
        pg8::EpiResRms E{args.in[0], args.out, DM, ALPHA, (const float*)(ws + WS_SSQ), 16, 1.0f / 1024.0f, RMS_EPS};
        pg8::gemm_phase<pg8::EpiResRms, pg8::StaticOrder, true, true>(lds, g, So, E);
    }
    SEAM();
    phase_ln(args.out, args.in[7], args.in[8], XB, gw, NGW, lane);
    SEAM();
    {
        pg8::Gemm g{XB, Wu, S, NUP, DM}; pg8::StaticOrder So; So.init(S, NUP, G, (int)blockIdx.x);
        pg8::EpiSwiglu E{H, DFF};
        pg8::gemm_phase<pg8::EpiSwiglu, pg8::StaticOrder, true, true>(lds, g, So, E);
    }
    SEAM();
    {
        pg8::Gemm g{H, Wd, S, DM, DFF}; pg8::StaticOrder So; So.init(S, DM, G, (int)blockIdx.x);
        pg8::EpiRes E{args.out, args.out, DM, ALPHA};
        pg8::gemm_phase<pg8::EpiRes, pg8::StaticOrder, true, true>(lds, g, So, E);
    }
    SEAM();
    phase_ln(args.out, args.in[11], args.in[12], nullptr, gw, NGW, lane);
}

extern "C" void kernel_launch(void* const* d_in, const int* in_sizes, int n_in, void* d_out, int out_size, void* d_ws, size_t ws_size, hipStream_t stream) {
    static int grid = 0;
    if (grid == 0) {
        if (n_in != 13 || in_sizes[0] != S * DM || out_size != S * DM || ws_size < WS_END) { fprintf(stderr, "kernel_launch: unexpected shapes (n_in %d, in0 %d, out %d, ws %zu)\n", n_in, n_in > 0 ? in_sizes[0] : -1, out_size, ws_size); grid = -1; return; }
        int dev = 0, cus = 0, per_cu = 0;
        if (hipGetDevice(&dev) != hipSuccess || hipDeviceGetAttribute(&cus, hipDeviceAttributeMultiprocessorCount, dev) != hipSuccess) { grid = -1; return; }
        if (hipFuncSetAttribute((const void*)hymba_fwd, hipFuncAttributeMaxDynamicSharedMemorySize, LDS_BYTES) != hipSuccess) { fprintf(stderr, "kernel_launch: hipFuncSetAttribute failed\n"); grid = -1; return; }
        if (hipOccupancyMaxActiveBlocksPerMultiprocessor(&per_cu, (const void*)hymba_fwd, NTHREADS, LDS_BYTES) != hipSuccess || per_cu < 1) { fprintf(stderr, "kernel_launch: occupancy query gave %d\n", per_cu); per_cu = 1; }
        (void)hipGetLastError();
        grid = cus * per_cu;
    }
    if (grid < 0) return;
    Args a{};
    for (int i = 0; i < 13; ++i) a.in[i] = (const float*)d_in[i];
    a.out = (float*)d_out; a.ws = (unsigned char*)d_ws;
    void* kargs[] = {&a};
    hipError_t e = hipLaunchCooperativeKernel((const void*)hymba_fwd, dim3(grid), dim3(NTHREADS), kargs, LDS_BYTES, stream);
    if (e != hipSuccess) fprintf(stderr, "cooperative launch failed: %s (grid %d)\n", hipGetErrorString(e), grid);
}
```
